# Optimizing an MI355X kernel written in HIP

```python
import jax, jax.numpy as jnp
from jax import lax
import numpy as np

D_MODEL = 1024
BATCH = 32
SEQ = 2048
DEPTH = 4
DEC_BATCH = 16
DEC_SEQ = 32
PAST_LEN = 1024

CHUNK = 64
N_HEADS = 16
HEAD_DIM = 64
N_KV_HEADS = 4
GQA_GROUP = N_HEADS // N_KV_HEADS
ATTN_WIDTH = N_HEADS * HEAD_DIM
KV_WIDTH = N_KV_HEADS * HEAD_DIM
WINDOW = 128
WINDOW_CHUNKS = WINDOW // CHUNK
POOL_WIDTH = D_MODEL
POOL_WINDOWS = (2, 4, 8, 16)
N_POOL_GROUPS = len(POOL_WINDOWS)
POOL_GROUP_WIDTH = POOL_WIDTH // N_POOL_GROUPS
POOL_HIST = max(POOL_WINDOWS) - 1
N_POOL_LAYERS = (DEPTH + 1) // 2
N_ATTN_LAYERS = DEPTH // 2
NORM_EPS = 1e-6
MASK_VALUE = -1e30

kernel_name = "chunk_streaming_pool_swa_hybrid_step"


def rms_norm(x, g):
    xf = x.astype(jnp.float32)
    y = xf * lax.rsqrt(jnp.mean(xf * xf, axis=-1, keepdims=True) + NORM_EPS)
    return (y * g.astype(jnp.float32)).astype(x.dtype)


def alibi_slopes():
    h = jnp.arange(1, N_HEADS + 1, dtype=jnp.float32)
    return jnp.exp2(-8.0 * h / N_HEADS)


def modulation(c, w, b):
    m = jnp.einsum('bd,de->be', jax.nn.silu(c), w) + b
    return jnp.split(m, 3, axis=-1)


def multiscale_pool(u, hist, hist_pos):
    B, T, E = u.shape
    u_ext = jnp.concatenate([hist.astype(u.dtype), u], axis=1)
    valid = jnp.concatenate([(hist_pos >= 0).astype(jnp.float32), jnp.ones((T,), jnp.float32)])
    cs = jnp.concatenate([jnp.zeros((B, 1, E), jnp.float32), jnp.cumsum(u_ext.astype(jnp.float32), axis=1)], axis=1)
    cv = jnp.concatenate([jnp.zeros((1,), jnp.float32), jnp.cumsum(valid)])
    uf = u.astype(jnp.float32)
    outs = []
    for g, w in enumerate(POOL_WINDOWS):
        sl = slice(g * POOL_GROUP_WIDTH, (g + 1) * POOL_GROUP_WIDTH)
        lo = POOL_HIST + 1 - w
        s = cs[:, POOL_HIST + 1:, sl] - cs[:, lo:lo + T, sl]
        n = cv[POOL_HIST + 1:] - cv[lo:lo + T]
        outs.append(s / n[None, :, None] - uf[..., sl])
    return jnp.stack(outs, axis=2), u_ext[:, -POOL_HIST:]


def pool_mixer(h, hist, hist_pos, w_in, w_grp, scale, w_out):
    B, T, _ = h.shape
    u, gate = jnp.split(h @ w_in, 2, axis=-1)
    pooled, new_hist = multiscale_pool(u, hist, hist_pos)
    z = jnp.einsum('btgc,gcd->btgd', pooled, w_grp.astype(jnp.float32)).reshape(B, T, POOL_WIDTH)
    z = z * scale.astype(jnp.float32)
    y = (z.astype(h.dtype) * jax.nn.silu(gate)) @ w_out
    return y, new_hist


def qkv_gate(h, w_in):
    B, T, _ = h.shape
    p = h @ w_in
    q, k, v, gate = jnp.split(p, [ATTN_WIDTH, ATTN_WIDTH + KV_WIDTH, ATTN_WIDTH + 2 * KV_WIDTH], axis=-1)
    return (q.reshape(B, T, N_KV_HEADS, GQA_GROUP, HEAD_DIM),
            k.reshape(B, T, N_KV_HEADS, HEAD_DIM),
            v.reshape(B, T, N_KV_HEADS, HEAD_DIM), gate)


def band_attend(q, k, v, qpos, kpos, sinks):
    s = jnp.einsum('bnqkgd,bnskd->bnkgqs', q.astype(jnp.float32), k.astype(jnp.float32)) * (HEAD_DIM ** -0.5)
    slopes = alibi_slopes().reshape(N_KV_HEADS, GQA_GROUP)
    dist = jnp.abs(qpos[:, :, None] - kpos[:, None, :]).astype(jnp.float32)
    qc = qpos[:, :, None] // CHUNK
    kc = kpos[:, None, :] // CHUNK
    allowed = (kpos[:, None, :] >= 0) & (kc <= qc) & (kc >= qc - WINDOW_CHUNKS)
    s = s - slopes[None, None, :, :, None, None] * dist[None, :, None, None]
    s = jnp.where(allowed[None, :, None, None], s, MASK_VALUE)
    sink = sinks.astype(jnp.float32).reshape(N_KV_HEADS, GQA_GROUP)[None, None, :, :, None]
    m = jnp.maximum(jnp.max(s, axis=-1), sink)
    p = jnp.exp(s - m[..., None])
    denom = jnp.sum(p, axis=-1) + jnp.exp(sink - m)
    return jnp.einsum('bnkgqs,bnskd->bnqkgd', p / denom[..., None], v.astype(jnp.float32))


def attn_prompt(h, w_in, sinks, w_out):
    B, T, _ = h.shape
    NC = T // CHUNK
    q, k, v, gate = qkv_gate(h, w_in)
    pad = WINDOW_CHUNKS * CHUNK

    def band(a):
        ap = jnp.pad(a, ((0, 0), (pad, 0), (0, 0), (0, 0))).reshape(B, NC + WINDOW_CHUNKS, CHUNK, N_KV_HEADS, HEAD_DIM)
        return jnp.concatenate([ap[:, j:j + NC] for j in range(WINDOW_CHUNKS + 1)], axis=2)

    qb = q.reshape(B, NC, CHUNK, N_KV_HEADS, GQA_GROUP, HEAD_DIM)
    qpos = jnp.arange(T, dtype=jnp.int32).reshape(NC, CHUNK)
    kpos = jnp.concatenate([qpos + (j - WINDOW_CHUNKS) * CHUNK for j in range(WINDOW_CHUNKS + 1)], axis=1)
    o = band_attend(qb, band(k), band(v), qpos, kpos, sinks).reshape(B, T, ATTN_WIDTH)
    y = (o.astype(h.dtype) * jax.nn.silu(gate)) @ w_out
    return y, k[:, -WINDOW:], v[:, -WINDOW:]


def attn_sample(h, k_cache, v_cache, w_in, sinks, w_out):
    B, T, _ = h.shape
    L = k_cache.shape[1]
    q, k, v, gate = qkv_gate(h, w_in)
    k_all = jnp.concatenate([k_cache.astype(k.dtype), k], axis=1)
    v_all = jnp.concatenate([v_cache.astype(v.dtype), v], axis=1)
    qpos = PAST_LEN + jnp.arange(T, dtype=jnp.int32)
    kpos = jnp.concatenate([PAST_LEN - L + jnp.arange(L, dtype=jnp.int32), qpos])
    o = band_attend(q[:, None], k_all[:, None], v_all[:, None], qpos[None], kpos[None], sinks)
    o = o[:, 0].reshape(B, T, ATTN_WIDTH)
    y = (o.astype(h.dtype) * jax.nn.silu(gate)) @ w_out
    return y, k_all[:, -L:], v_all[:, -L:]


def setup_inputs(seed: int = 0) -> dict:
    key = jax.random.key(seed)
    ks = jax.random.split(key, 18)
    nrm = jax.random.normal
    f32 = jnp.float32
    return {
        "x_prompt": nrm(ks[0], (BATCH, SEQ, D_MODEL), f32),
        "x_sample": nrm(ks[1], (DEC_BATCH, DEC_SEQ, D_MODEL), f32),
        "c_prompt": nrm(ks[2], (BATCH, D_MODEL), f32),
        "c_sample": nrm(ks[3], (DEC_BATCH, D_MODEL), f32),
        "cache_pool": nrm(ks[4], (N_POOL_LAYERS, DEC_BATCH, POOL_HIST, POOL_WIDTH), f32),
        "cache_k": nrm(ks[5], (N_ATTN_LAYERS, DEC_BATCH, min(WINDOW, PAST_LEN), N_KV_HEADS, HEAD_DIM), f32),
        "cache_v": nrm(ks[6], (N_ATTN_LAYERS, DEC_BATCH, min(WINDOW, PAST_LEN), N_KV_HEADS, HEAD_DIM), f32),
        "norm_g": 1.0 + 0.1 * nrm(ks[7], (DEPTH, D_MODEL), f32),
        "ada_w": 0.5 * D_MODEL ** -0.5 * nrm(ks[8], (DEPTH, D_MODEL, 3 * D_MODEL), f32),
        "ada_b": 0.02 * nrm(ks[9], (DEPTH, 3 * D_MODEL), f32),
        "pool_w_in": D_MODEL ** -0.5 * nrm(ks[10], (N_POOL_LAYERS, D_MODEL, 2 * POOL_WIDTH), f32),
        "pool_w_grp": POOL_GROUP_WIDTH ** -0.5 * nrm(ks[11], (N_POOL_LAYERS, N_POOL_GROUPS, POOL_GROUP_WIDTH, POOL_GROUP_WIDTH), f32),
        "pool_scale": 1.0 + 0.1 * nrm(ks[12], (N_POOL_LAYERS, POOL_WIDTH), f32),
        "pool_w_out": POOL_WIDTH ** -0.5 * nrm(ks[13], (N_POOL_LAYERS, POOL_WIDTH, D_MODEL), f32),
        "attn_w_in": D_MODEL ** -0.5 * nrm(ks[14], (N_ATTN_LAYERS, D_MODEL, 2 * ATTN_WIDTH + 2 * KV_WIDTH), f32),
        "attn_sinks": nrm(ks[15], (N_ATTN_LAYERS, N_HEADS), f32),
        "attn_w_out": ATTN_WIDTH ** -0.5 * nrm(ks[16], (N_ATTN_LAYERS, ATTN_WIDTH, D_MODEL), f32),
        "final_g": 1.0 + 0.1 * nrm(ks[17], (D_MODEL,), f32),
    }


def reference(x_prompt, x_sample, c_prompt, c_sample, cache_pool, cache_k, cache_v,
              norm_g, ada_w, ada_b, pool_w_in, pool_w_grp, pool_scale, pool_w_out,
              attn_w_in, attn_sinks, attn_w_out, final_g):

    def trunk(x, c, sample):
        B = x.shape[0]
        pool_states, k_states, v_states = [], [], []
        for i in range(DEPTH):
            j = i // 2
            shift, scale, gate = modulation(c, ada_w[i], ada_b[i])
            h = rms_norm(x, norm_g[i]) * (1 + scale[:, None]) + shift[:, None]
            if i % 2 == 0:
                if sample:
                    hist = cache_pool[j]
                    hist_pos = PAST_LEN - POOL_HIST + jnp.arange(POOL_HIST, dtype=jnp.int32)
                else:
                    hist = jnp.zeros((B, POOL_HIST, POOL_WIDTH), h.dtype)
                    hist_pos = jnp.arange(POOL_HIST, dtype=jnp.int32) - POOL_HIST
                y, st = pool_mixer(h, hist, hist_pos, pool_w_in[j], pool_w_grp[j], pool_scale[j], pool_w_out[j])
                pool_states.append(st)
            else:
                if sample:
                    y, kw, vw = attn_sample(h, cache_k[j], cache_v[j], attn_w_in[j], attn_sinks[j], attn_w_out[j])
                else:
                    y, kw, vw = attn_prompt(h, attn_w_in[j], attn_sinks[j], attn_w_out[j])
                k_states.append(kw)
                v_states.append(vw)
            x = x + gate[:, None] * y
        return rms_norm(x, final_g), jnp.stack(pool_states), jnp.stack(k_states), jnp.stack(v_states)

    y_prompt, pool_p, k_p, v_p = trunk(x_prompt, c_prompt, False)
    y_sample, pool_s, k_s, v_s = trunk(x_sample, c_sample, True)
    return (y_prompt, y_sample, pool_p, k_p, v_p, pool_s, k_s, v_s)
```

```cpp
#include <hip/hip_runtime.h>
#include <hip/hip_cooperative_groups.h>
#include <cstdio>
#include <cstdint>
namespace cg = cooperative_groups;
namespace pg8 {
#define PG8_LAS __attribute__((address_space(3)))
typedef unsigned short bf16_t;
typedef short bf16x8 __attribute__((ext_vector_type(8)));
typedef float f32x4 __attribute__((ext_vector_type(4)));
typedef unsigned u32x4 __attribute__((ext_vector_type(4)));
constexpr int BM = 256, BK = 64, HALF = 128, HTB = HALF * BK * 2  , STAGE_BYTES = 8 * HTB, NXCD = 8, WGM = 8;

__host__ __device__ __forceinline__ int lds_byte(int r, int c) { const int st = (r >> 4) * 2 + (c >> 5), rr = r & 15, cc = c & 31, ob = rr * 64 + cc * 2; return st * 1024 + (ob ^ (((ob >> 9) & 1) << 5)); }
__host__ __device__ __forceinline__ void stage_rc(int b, int& R, int& C) { const int st = b / 1024, sb = b % 1024, swz = sb ^ (((sb >> 9) & 1) << 5); R = (st >> 1) * 16 + swz / 64; C = (st & 1) * 32 + (swz % 64) / 2; }
__host__ __device__ __forceinline__ int perm32(int rho) { const int n = rho >> 4, i = rho & 15; return 8 * (i >> 2) + 4 * n + (i & 3); }

struct Unit { int pm, pn; };
struct Gemm { const bf16_t* A; const bf16_t* Bt; int M, N, K; };

template <class Epi, class Sched, bool ALIGN_EPI = false, bool SP2 = false>
__device__ __forceinline__ void gemm_phase(PG8_LAS unsigned char* lds, const Gemm g, const Sched& S, const Epi& E) {
    int tid; asm volatile("v_mov_b32 %0, %1" : "=v"(tid) : "v"((int)threadIdx.x));
    const int wid = __builtin_amdgcn_readfirstlane(tid >> 6), lane = tid & 63, wr = wid >> 2, wc = wid & 3, fr = lane & 15, fq = lane >> 4;
    const int K = g.K, nt = K / BK;
    unsigned voffA[2], voffB[2];
#pragma unroll
    for (int i = 0; i < 2; ++i) { int R, C; stage_rc(tid * 16 + i * 8192, R, C); const int Rb = Epi::PERM64 ? ((R >> 5) * 64 + perm32(R & 31)) : (Epi::PERM ? ((R & ~31) + perm32(R & 31)) : R);
        voffA[i] = (unsigned)(R * K + C) * 2u; voffB[i] = (unsigned)(Rb * K + C) * 2u; }
    const size_t kstep = (size_t)(BK * 2);
    const size_t hstep = (size_t)HALF * K * 2;
    const size_t hstepB = Epi::PERM64 ? (size_t)32 * K * 2 : hstep;
    const size_t tstep = 2 * hstep;
    const unsigned ldsw = (unsigned)wid * 1024u;
    const int aoff = lds_byte(wr * 64 + fr, fq * 8), boff = lds_byte(wc * 32 + fr, fq * 8);
#define PG8_SA(b, h) (((b) * 2 + (h)) * HTB)
#define PG8_SB(b, h) ((4 + (b) * 2 + (h)) * HTB)
#define PG8_STAGE(bufoff, gbase, voff) do { _Pragma("unroll") for (int _i = 0; _i < 2; ++_i) \
        __builtin_amdgcn_global_load_lds((const unsigned*)((const char*)(gbase) + (voff)[_i]), (PG8_LAS unsigned*)(lds + (bufoff) + ldsw + _i * 8192), 16, 0, 0); } while (0)
#define PG8_LDA(dst, b, h) do { _Pragma("unroll") for (int m = 0; m < 4; ++m) _Pragma("unroll") for (int k = 0; k < 2; ++k) dst[m][k] = *(const PG8_LAS bf16x8*)(lds + PG8_SA(b, h) + aoff + m * 2048 + k * 1024); } while (0)
#define PG8_LDB(dst, b, h) do { _Pragma("unroll") for (int n = 0; n < 2; ++n) _Pragma("unroll") for (int k = 0; k < 2; ++k) dst[n][k] = *(const PG8_LAS bf16x8*)(lds + PG8_SB(b, h) + boff + n * 2048 + k * 1024); } while (0)
#define PG8_MMA(ai, bj, At, Bt) do { __builtin_amdgcn_s_setprio(1); _Pragma("unroll") for (int m = 0; m < 4; ++m) _Pragma("unroll") for (int n = 0; n < 2; ++n) _Pragma("unroll") for (int k = 0; k < 2; ++k) \
        acc[ai][bj][m][n] = __builtin_amdgcn_mfma_f32_16x16x32_bf16(Bt[n][k], At[m][k], acc[ai][bj][m][n], 0, 0, 0); __builtin_amdgcn_s_setprio(0); } while (0)
#define PG8_WAIT_V(n) asm volatile("s_waitcnt vmcnt(" #n ")" ::: "memory")
#define PG8_WAIT_L(n) asm volatile("s_waitcnt lgkmcnt(" #n ")" ::: "memory")
#define PG8_BAR __builtin_amdgcn_s_barrier()
#define PG8_SCHED __builtin_amdgcn_sched_barrier(0)
    Unit cur, nxt; int ui = 0;
    if (!S.next(0, cur)) return;
    f32x4 acc[2][2][4][2];
#pragma unroll
    for (int a = 0; a < 2; ++a)
#pragma unroll
        for (int b = 0; b < 2; ++b)
#pragma unroll
            for (int m = 0; m < 4; ++m)
#pragma unroll
                for (int n = 0; n < 2; ++n) acc[a][b][m][n] = (f32x4){0.f, 0.f, 0.f, 0.f};
    bf16x8 At[4][2], B0[2][2], B1[2][2];
    const char* cA = (const char*)g.A + (size_t)cur.pm * tstep; const char* cB = (const char*)g.Bt + (size_t)cur.pn * tstep;
    S.a_ready(cur);
    if constexpr (SP2) {
        PG8_STAGE(PG8_SB(0, 0), cB, voffB); PG8_STAGE(PG8_SB(0, 1), cB + hstepB, voffB); PG8_STAGE(PG8_SA(0, 0), cA, voffA); PG8_STAGE(PG8_SA(0, 1), cA + hstep, voffA);
        if (wr == 1) PG8_BAR;
        PG8_WAIT_V(2); PG8_BAR;
        PG8_STAGE(PG8_SB(1, 0), cB + kstep, voffB); PG8_STAGE(PG8_SA(1, 0), cA + kstep, voffA); PG8_STAGE(PG8_SB(1, 1), cB + hstepB + kstep, voffB);
        PG8_WAIT_V(6); PG8_BAR;
    } else {
        PG8_STAGE(PG8_SB(0, 0), cB, voffB); PG8_STAGE(PG8_SA(0, 0), cA, voffA); PG8_STAGE(PG8_SB(0, 1), cB + hstepB, voffB); PG8_STAGE(PG8_SA(0, 1), cA + hstep, voffA);
        if (wr == 1) PG8_BAR;
        PG8_WAIT_V(4); PG8_BAR;
        PG8_STAGE(PG8_SB(1, 0), cB + kstep, voffB); PG8_STAGE(PG8_SA(1, 0), cA + kstep, voffA); PG8_STAGE(PG8_SB(1, 1), cB + hstepB + kstep, voffB);
        PG8_WAIT_V(6); PG8_BAR;
    }
    for (;;) {
        const bool has_next = S.next(ui + 1, nxt);
        if constexpr (Epi::STAGE) E.stage(cur, lds, tid, wid, ui & 1);
        const char* nA = has_next ? (const char*)g.A + (size_t)nxt.pm * tstep : cA; const char* nB = has_next ? (const char*)g.Bt + (size_t)nxt.pn * tstep : cB;
        for (int t = 0; t < nt; t += 2) {
            const bool last = (t == nt - 2);
            const char* a1 = cA + (size_t)(t + 1) * kstep;
            const char* a2 = last ? nA : cA + (size_t)(t + 2) * kstep; const char* b2 = last ? nB : cB + (size_t)(t + 2) * kstep;
            const char* a3 = a2 + kstep; const char* b3 = b2 + kstep;
            if (last && has_next) S.a_ready(nxt);
            if constexpr (SP2) {
            PG8_LDB(B0, 0, 0); PG8_LDB(B1, 0, 1); PG8_SCHED; PG8_LDA(At, 0, 0); PG8_STAGE(PG8_SA(1, 1), a1 + hstep, voffA);
            PG8_WAIT_V(8); PG8_WAIT_L(0); PG8_BAR; PG8_MMA(0, 0, At, B0); PG8_MMA(0, 1, At, B1); PG8_BAR; PG8_SCHED;
            PG8_LDA(At, 0, 1); PG8_STAGE(PG8_SB(0, 0), b2, voffB); PG8_STAGE(PG8_SB(0, 1), b2 + hstepB, voffB); PG8_STAGE(PG8_SA(0, 0), a2, voffA);
            PG8_WAIT_V(8); PG8_WAIT_L(0); PG8_BAR; PG8_MMA(1, 0, At, B0); PG8_MMA(1, 1, At, B1); PG8_BAR; PG8_SCHED;
            PG8_LDB(B0, 1, 0); PG8_LDB(B1, 1, 1); PG8_SCHED; PG8_LDA(At, 1, 0); PG8_STAGE(PG8_SA(0, 1), a2 + hstep, voffA);
            PG8_WAIT_V(8); PG8_WAIT_L(0); PG8_BAR; PG8_MMA(0, 0, At, B0); PG8_MMA(0, 1, At, B1); PG8_BAR; PG8_SCHED;
            PG8_LDA(At, 1, 1); PG8_STAGE(PG8_SB(1, 0), b3, voffB); PG8_STAGE(PG8_SB(1, 1), b3 + hstepB, voffB); PG8_STAGE(PG8_SA(1, 0), a3, voffA);
            PG8_WAIT_V(8); PG8_WAIT_L(0); PG8_BAR; PG8_MMA(1, 0, At, B0); PG8_MMA(1, 1, At, B1); PG8_BAR; PG8_SCHED;
            } else {
            PG8_LDB(B0, 0, 0); PG8_SCHED; PG8_LDA(At, 0, 0); PG8_STAGE(PG8_SA(1, 1), a1 + hstep, voffA);
            PG8_WAIT_L(8); PG8_BAR; PG8_WAIT_L(0); PG8_MMA(0, 0, At, B0); PG8_BAR; PG8_SCHED;
            PG8_LDB(B1, 0, 1); PG8_STAGE(PG8_SB(0, 0), b2, voffB);
            PG8_BAR; PG8_WAIT_L(0); PG8_MMA(0, 1, At, B1); PG8_BAR;
            PG8_LDA(At, 0, 1); PG8_STAGE(PG8_SA(0, 0), a2, voffA);
            PG8_BAR; PG8_WAIT_L(0); PG8_MMA(1, 0, At, B0); PG8_BAR; PG8_SCHED;
            PG8_STAGE(PG8_SB(0, 1), b2 + hstepB, voffB);
            PG8_WAIT_V(6); PG8_BAR; PG8_MMA(1, 1, At, B1); PG8_BAR;
            PG8_LDB(B0, 1, 0); PG8_SCHED; PG8_LDA(At, 1, 0); PG8_STAGE(PG8_SA(0, 1), a2 + hstep, voffA);
            PG8_WAIT_L(8); PG8_BAR; PG8_WAIT_L(0); PG8_MMA(0, 0, At, B0); PG8_BAR; PG8_SCHED;
            PG8_LDB(B1, 1, 1); PG8_STAGE(PG8_SB(1, 0), b3, voffB);
            PG8_BAR; PG8_WAIT_L(0); PG8_MMA(0, 1, At, B1); PG8_BAR;
            PG8_LDA(At, 1, 1); PG8_STAGE(PG8_SA(1, 0), a3, voffA);
            PG8_BAR; PG8_WAIT_L(0); PG8_MMA(1, 0, At, B0); PG8_BAR; PG8_SCHED;
            PG8_STAGE(PG8_SB(1, 1), b3 + hstepB, voffB);
            PG8_WAIT_V(6); PG8_BAR; PG8_MMA(1, 1, At, B1); PG8_BAR;
            }
        }
        if constexpr (ALIGN_EPI) { if (wr == 0) PG8_BAR; }
#ifndef PF_NEXT_A
#define PF_NEXT_A 0
#endif
        if (PF_NEXT_A && Epi::PF && has_next) {
            const char* pp = nA + (size_t)(tid >> 4) * (size_t)(K * 2) + (size_t)(tid & 15) * 128;
#pragma unroll 1
            for (int i = 0; i < 8; ++i) { __builtin_amdgcn_global_load_lds((const unsigned*)pp, (PG8_LAS unsigned*)(lds + 135168 + wid * 256), 4, 0, 0); pp += (size_t)32 * (size_t)(K * 2); }
        }
        if constexpr (!Epi::AFTER_DRAIN) { E(acc, cur, wr, wc, fr, fq, ui & 1); S.done(cur); }
        if (!has_next) break;
#pragma unroll
        for (int a = 0; a < 2; ++a)
#pragma unroll
            for (int b = 0; b < 2; ++b)
#pragma unroll
                for (int m = 0; m < 4; ++m)
#pragma unroll
                    for (int n = 0; n < 2; ++n) acc[a][b][m][n] = (f32x4){0.f, 0.f, 0.f, 0.f};
        cur = nxt; cA = nA; cB = nB; ++ui;
        if constexpr (ALIGN_EPI) { if (wr == 1) PG8_BAR; }
    }
    PG8_WAIT_V(0);
    if constexpr (!ALIGN_EPI) { if (wr == 0) PG8_BAR; }
    PG8_BAR;
    if constexpr (Epi::AFTER_DRAIN) { E.fused(acc, cur, wr, wc, fr, fq, lds, wid, lane); S.done(cur); }
#undef PG8_SA
#undef PG8_SB
#undef PG8_STAGE
#undef PG8_LDA
#undef PG8_LDB
#undef PG8_MMA
#undef PG8_WAIT_V
#undef PG8_WAIT_L
#undef PG8_BAR
#undef PG8_SCHED
}
}
namespace pg8 {
struct TileOrder {
    int nM, nN, nwg, G, c, nextra, rev, wgm;
    __device__ __forceinline__ void init(int nM_, int nN_, int G_, int c_, int nextra_, int rev_, int wgm_) { nM = nM_; nN = nN_; nwg = nM * nN; G = G_; c = c_; nextra = nextra_; rev = rev_; wgm = wgm_; }
    __device__ __forceinline__ bool next(int i, Unit& u) const {
        long L = (long)i * G + c; if (L >= nwg + nextra) return false;
        if (rev) L = (long)(nwg + nextra) - 1 - L;
        if (L >= nwg) { const int e = (int)L - nwg, ti = e >> 2; u.pn = 8 + (e & 3); u.pm = ti < 32 ? 8 * ti + 7 : 256 + (ti - 32); return true; }
        int wgid = (int)L; { const int q = nwg / NXCD, r = nwg % NXCD, xcd = wgid % NXCD, off = wgid / NXCD; wgid = (xcd < r ? xcd * (q + 1) : r * (q + 1) + (xcd - r) * q) + off; }
        const int nig = wgm * nN, gid = wgid / nig, fm = gid * wgm, gsz = (nM - fm) < wgm ? (nM - fm) : wgm;
        u.pm = fm + ((wgid % nig) % gsz); u.pn = (wgid % nig) / gsz; return true;
    }
    __device__ __forceinline__ void a_ready(const Unit&) const {}
    __device__ __forceinline__ void done(const Unit&) const {}
};
}
#define GAS __attribute__((address_space(1)))
#define LAS __attribute__((address_space(3)))
#define DI __device__ __forceinline__
using pg8::bf16_t; using pg8::bf16x8; using pg8::f32x4; using pg8::u32x4; using pg8::Unit;
typedef float f32x16 __attribute__((ext_vector_type(16)));
typedef float f32x2_t __attribute__((ext_vector_type(2)));
typedef __bf16 bf16x2_t __attribute__((ext_vector_type(2)));
typedef short s16x4 __attribute__((ext_vector_type(4)));
typedef unsigned u32x2 __attribute__((ext_vector_type(2)));

constexpr int D = 1024, SEQ = 2048, MP = 32 * 2048, MS = 16 * 32, R = MP + MS, NB = 48;
constexpr int NWAVES = 8, NTHR = 512;
constexpr float EPS = 1e-6f, LOG2E = 1.4426950408889634f, QSCALE = 0.125f * LOG2E;
constexpr int LDS_BYTES = 153600;
constexpr int LDS_RED = 131072;
constexpr int LDS_STG = 137216;
constexpr int LDS_MISC = 152576;
constexpr size_t OFF_YS = 67108864, OFF_PP = 67633152, OFF_KP = 68616192, OFF_VP = 70713344, OFF_PS = 72810496, OFF_KS = 73302016, OFF_VS = 74350592, OUT_TOTAL = 75399168;
constexpr size_t MiB = 1u << 20;
constexpr size_t WS_BAR = 0  , WS_MOD = 2 * MiB, WS_BIAS = 5 * MiB, WS_WP = 8 * MiB, WS_HV = 16 * MiB, WS_POOLBT = 18 * MiB, WS_ATTNBT = 30 * MiB, WS_POOLOUT = 40 * MiB, WS_ATTNOUT = 44 * MiB;
constexpr size_t WS_XA = 48 * MiB, WS_B1 = 177 * MiB, WS_B2 = 306 * MiB, WS_B3 = 435 * MiB, WS_KB = 564 * MiB, WS_VB = 597 * MiB, WS_SSQ = 630 * MiB  , WS_XB = 636 * MiB  , WS_END = 765 * MiB;
static_assert((size_t)R * D * 2 <= 129 * MiB && (size_t)R * 256 * 2 <= 33 * MiB, "ws map");

DI int opaque_tid() { int t; asm volatile("v_mov_b32 %0, %1" : "=v"(t) : "v"((int)threadIdx.x)); return t; }
DI unsigned cvtpk(float lo, float hi) { f32x2_t v = {lo, hi}; bf16x2_t b = __builtin_convertvector(v, bf16x2_t); return __builtin_bit_cast(unsigned, b); }
DI float bf_lo(unsigned u) { return __uint_as_float(u << 16); }
DI float bf_hi(unsigned u) { return __uint_as_float(u & 0xffff0000u); }
DI float silu_f(float x) { return x * __builtin_amdgcn_rcpf(1.f + __expf(-x)); }
DI int row_mb(int row) { return row < MP ? (row >> 11) : 32 + ((row - MP) >> 5); }
DI u32x4 pack8(f32x4 a, f32x4 b) { u32x4 w; w.x = cvtpk(a.x, a.y); w.y = cvtpk(a.z, a.w); w.z = cvtpk(b.x, b.y); w.w = cvtpk(b.z, b.w); return w; }
DI void unpack8(u32x4 w, float (&f)[8]) { f[0] = bf_lo(w.x); f[1] = bf_hi(w.x); f[2] = bf_lo(w.y); f[3] = bf_hi(w.y); f[4] = bf_lo(w.z); f[5] = bf_hi(w.z); f[6] = bf_lo(w.w); f[7] = bf_hi(w.w); }

struct Args { const float* in[18]; float* out; unsigned char* ws; int ph_lo, ph_hi; };
typedef const volatile __attribute__((address_space(4))) Args* KArgs;

#ifndef WGM_IN
#define WGM_IN 8
#endif
#ifndef WGM_OUT
#define WGM_OUT 8
#endif
#ifndef SMALL_OUT
#define SMALL_OUT 1
#endif
#ifndef EPI_PROBE
#define EPI_PROBE 0
#endif
#ifndef PF_IN
#define PF_IN true
#endif
#ifndef PF_OUT
#define PF_OUT true
#endif
DI u32x4 dpp_ror8(u32x4 v) { u32x4 r; r.x = (unsigned)__builtin_amdgcn_mov_dpp((int)v.x, 0x128, 0xf, 0xf, true); r.y = (unsigned)__builtin_amdgcn_mov_dpp((int)v.y, 0x128, 0xf, 0xf, true);
    r.z = (unsigned)__builtin_amdgcn_mov_dpp((int)v.z, 0x128, 0xf, 0xf, true); r.w = (unsigned)__builtin_amdgcn_mov_dpp((int)v.w, 0x128, 0xf, 0xf, true); return r; }
DI void store_pair(bf16_t* base, int ld, int rowbase, int fr, int c0, u32x4 p0, u32x4 p1) {
    const bool lo = fr < 8;
    const u32x4 recv = dpp_ror8(lo ? p1 : p0);
    bf16_t* a = base + (size_t)(rowbase + (fr & 7)) * ld + c0 + (fr >> 3) * 32;
    *(u32x4*)a = lo ? p0 : recv; *(u32x4*)(a + (size_t)8 * ld) = lo ? recv : p1;
}
DI void load_pair(const bf16_t* base, int ld, int rowbase, int fr, int c0, u32x4& p0, u32x4& p1) {
    const bool lo = fr < 8;
    const bf16_t* a = base + (size_t)(rowbase + (fr & 7)) * ld + c0 + (fr >> 3) * 32;
    const u32x4 A = *(const u32x4*)a, B = *(const u32x4*)(a + (size_t)8 * ld);
    const u32x4 recv = dpp_ror8(lo ? B : A);
    p0 = lo ? A : recv; p1 = lo ? recv : B;
}
struct EpiIn {
    static constexpr bool PERM = true, PERM64 = true, AFTER_DRAIN = false, PF = PF_IN, STAGE = true; static constexpr int NPF = 8;
    int li_;
    KArgs ka; LAS unsigned char* lds_;
    DI void stage(const Unit& u, LAS unsigned char* lds, int tid, int wid, int par) const {
        unsigned char* ws = ka->ws; const int li = li_ & 255;
        LAS unsigned char* st = lds + LDS_STG + par * 5120;
        if (wid < 4) __builtin_amdgcn_global_load_lds((const unsigned*)((const float*)(ws + WS_SSQ) + ((size_t)li * R + (size_t)u.pm * 256 + tid) * 4), (LAS unsigned*)(st + wid * 1024), 16, 0, 0);
        if (wid == 4 && u.pm < 256) __builtin_amdgcn_global_load_lds((const unsigned*)((const float*)(ws + WS_BIAS) + (size_t)li * NB * 3072 + (u.pm >> 3) * 3072 + u.pn * 256 + (tid & 63) * 4), (LAS unsigned*)(st + 4096), 16, 0, 0);
    }
    DI void operator()(const f32x4 (&acc)[2][2][4][2], const Unit& u, int wr, int wc, int fr, int fq, int par) const {
        const int li = li_ & 255;
        const LAS unsigned char* st = lds_ + LDS_STG + par * 5120;
        if (EPI_PROBE && (li_ & 256)) { if (acc[0][0][0][0].x == 1.2345e30f) asm volatile("s_nop 0"); return; }
        const int pn = u.pn, attn = li & 1, j = li >> 1;
        unsigned char* ws = ka->ws; float* out = ka->out;
        const float* ssq = (const float*)(ws + WS_SSQ) + (size_t)li * R * 4; const float* biasv = (const float*)(ws + WS_BIAS) + (size_t)li * NB * 3072;
        bf16_t* B1 = (bf16_t*)(ws + WS_B1); bf16_t* B2 = (bf16_t*)(ws + WS_B2); bf16_t* KB = (bf16_t*)(ws + WS_KB); bf16_t* VB = (bf16_t*)(ws + WS_VB);
        float* o_pp = out + OFF_PP + (size_t)j * 32 * 15 * 1024; float* o_ps = out + OFF_PS + (size_t)j * 16 * 15 * 1024;
        float* o_kp = out + OFF_KP + (size_t)j * 32 * 128 * 256; float* o_vp = out + OFF_VP + (size_t)j * 32 * 128 * 256; float* o_ks = out + OFF_KS + (size_t)j * 16 * 128 * 256; float* o_vs = out + OFF_VS + (size_t)j * 16 * 128 * 256;
        int kind, cbase; float qs = 1.f;
        if (!attn) { kind = pn < 4 ? 0 : (pn < 8 ? 1 : 4); cbase = pn < 4 ? 0 : (pn < 8 ? 1024 : 2048); }
        else if (pn < 4) { kind = 0; cbase = 0; qs = QSCALE; }
        else if (pn == 4) { kind = 2; cbase = 1024; }
        else if (pn == 5) { kind = 3; cbase = 1280; }
        else { kind = 1; cbase = 1536; }
        const int colg = pn * 256 + wc * 64 + 8 * fq;
        if (u.pm < 256) rows<true>(acc, u, wr, wc, fq, st, fr, kind, attn != 0, cbase, qs, colg, ssq, biasv, B1, B2, KB, VB, o_pp, o_ps, o_kp, o_vp, o_ks, o_vs);
        else rows<false>(acc, u, wr, wc, fq, st, fr, kind, attn != 0, cbase, qs, colg, ssq, biasv, B1, B2, KB, VB, o_pp, o_ps, o_kp, o_vp, o_ks, o_vs);
    }
    template <bool UNI> DI void rows(const f32x4 (&acc)[2][2][4][2], const Unit& u, int wr, int wc, int fq, const LAS unsigned char* st, int fr, int kind, bool silu_here, int cbase, float qs, int colg, const float* ssq, const float* biasv,
                                     bf16_t* B1, bf16_t* B2, bf16_t* KB, bf16_t* VB, float* o_pp, float* o_ps, float* o_kp, float* o_vp, float* o_ks, float* o_vs) const {
        f32x4 bu[2][2];
        if (UNI) {
#pragma unroll
            for (int bj = 0; bj < 2; ++bj)
#pragma unroll
                for (int n = 0; n < 2; ++n) bu[bj][n] = *(const LAS f32x4*)(st + 4096 + (wc * 64 + 8 * fq + bj * 32 + 4 * n) * 4);
        }
#pragma unroll
        for (int ai = 0; ai < 2; ++ai)
#pragma unroll
            for (int m = 0; m < 4; ++m) {
                const int rowbase = u.pm * 256 + ai * 128 + wr * 64 + m * 16, row = rowbase + fr;
                const f32x4 sp = *(const LAS f32x4*)(st + (ai * 128 + wr * 64 + m * 16 + fr) * 16);
                const float rs = rsqrtf(((sp.x + sp.y) + (sp.z + sp.w)) * (1.f / 1024.f) + EPS);
                const float* bp = biasv + (UNI ? 0 : row_mb(row)) * 3072 + colg;
                u32x4 P[2];
#pragma unroll
                for (int bj = 0; bj < 2; ++bj) {
                    const f32x4 b0 = UNI ? bu[bj][0] : *(const f32x4*)(bp + bj * 32), b1 = UNI ? bu[bj][1] : *(const f32x4*)(bp + bj * 32 + 4);
                    f32x4 v0 = acc[ai][bj][m][0] * rs + b0, v1 = acc[ai][bj][m][1] * rs + b1;
                    const int c = colg + bj * 32 - cbase;
                    if (kind == 0) { v0 = v0 * qs; v1 = v1 * qs; }
                    else if (kind == 1) {
                        if (silu_here) {
                            v0.x = silu_f(v0.x); v0.y = silu_f(v0.y); v0.z = silu_f(v0.z); v0.w = silu_f(v0.w);
                            v1.x = silu_f(v1.x); v1.y = silu_f(v1.y); v1.z = silu_f(v1.z); v1.w = silu_f(v1.w);
                        }
                    } else if (kind == 4) {
                        float* dst = nullptr;
                        if (row < MP) { const int t = row & 2047; if (t >= SEQ - 15) dst = o_pp + ((size_t)(row >> 11) * 15 + (t - (SEQ - 15))) * 1024 + c; }
                        else { const int t = (row - MP) & 31; if (t >= 17) dst = o_ps + ((size_t)((row - MP) >> 5) * 15 + (t - 17)) * 1024 + c; }
                        if (dst) { *(f32x4*)dst = v0; *(f32x4*)(dst + 4) = v1; }
                    } else {
                        float* dst = nullptr;
                        if (row < MP) { const int t = row & 2047; if (t >= SEQ - 128) dst = (kind == 2 ? o_kp : o_vp) + ((size_t)(row >> 11) * 128 + (t - (SEQ - 128))) * 256 + c; }
                        else { const int t = (row - MP) & 31; dst = (kind == 2 ? o_ks : o_vs) + ((size_t)((row - MP) >> 5) * 128 + 96 + t) * 256 + c; }
                        if (dst) { *(f32x4*)dst = v0; *(f32x4*)(dst + 4) = v1; }
                    }
                    P[bj] = pack8(v0, v1);
                }
                if (kind == 0) store_pair(B1, 1024, rowbase, fr, colg - cbase, P[0], P[1]);
                else if (kind == 1) store_pair(B2, 1024, rowbase, fr, colg - cbase, P[0], P[1]);
                else if (kind == 2) store_pair(KB, 256, rowbase, fr, colg - cbase, P[0], P[1]);
                else if (kind == 3) store_pair(VB, 256, rowbase, fr, colg - cbase, P[0], P[1]);
            }
    }
};

struct EpiOut {
    static constexpr bool PERM = true, PERM64 = true, AFTER_DRAIN = false, PF = PF_OUT, STAGE = false; static constexpr int NPF = 4;
    int li_; KArgs ka; LAS unsigned char* lds;
    DI void operator()(const f32x4 (&acc)[2][2][4][2], const Unit& u, int wr, int wc, int fr, int fq, int) const {
        const int li = li_ & 255;
        if (li_ >> 8) { if (acc[0][0][0][0].x == 1.2345e30f) asm volatile("s_nop 0"); return; }
        const float* xp_in = ka->in[0]; const float* xs_in = ka->in[1]; const float* norm_g = ka->in[7]; float* xo = ka->out; unsigned char* ws = ka->ws;
        const float* xp = xp_in; const float* xs = xs_in; bf16_t* XB = (bf16_t*)(ws + WS_XB);
        const float* gmod = (const float*)(ws + WS_MOD) + (size_t)li * NB * 3072;
        const float* ng = li == 3 ? nullptr : norm_g + (li + 1) * 1024;
        const float* nmod = gmod + NB * 3072;
        bf16_t* XA = (bf16_t*)(ws + WS_XA); float* ssq = (float*)(ws + WS_SSQ) + (size_t)(li + 1) * R * 4;
        const int colg = u.pn * 256 + wc * 64 + 8 * fq;
        if (u.pm < 256) rows<true>(acc, u, wr, wc, fr, fq, colg, li == 0, xp, xs, XB, gmod, ng, nmod, XA);
        else rows<false>(acc, u, wr, wc, fr, fq, colg, li == 0, xp, xs, XB, gmod, ng, nmod, XA);
        asm volatile("s_waitcnt lgkmcnt(0)" ::: "memory"); __builtin_amdgcn_s_barrier();
        const int t = (wr * 4 + wc) * 64 + fq * 16 + fr;
        if (t < 256) { const f32x4 pr = *(const LAS f32x4*)(lds + LDS_RED + t * 16); ssq[((size_t)u.pm * 256 + t) * 4 + u.pn] = (pr.x + pr.y) + (pr.z + pr.w); }
    }
    template <bool UNI> DI void rows(const f32x4 (&acc)[2][2][4][2], const Unit& u, int wr, int wc, int fr, int fq, int colg, bool first, const float* xp, const float* xs, bf16_t* XB,
                                     const float* gmod, const float* ng, const float* nmod, bf16_t* XA) const {
        f32x4 gu[2][2], au[2][2];
        if (UNI) {
            const int mbu = u.pm >> 3;
#pragma unroll
            for (int bj = 0; bj < 2; ++bj)
#pragma unroll
                for (int n = 0; n < 2; ++n) { const int c = colg + bj * 32 + 4 * n; gu[bj][n] = *(const f32x4*)(gmod + mbu * 3072 + 2048 + c);
                    au[bj][n] = (f32x4){0.f, 0.f, 0.f, 0.f}; if (ng) au[bj][n] = *(const f32x4*)(ng + c) * (*(const f32x4*)(nmod + mbu * 3072 + 1024 + c) + 1.f); }
        }
#pragma unroll
        for (int ai = 0; ai < 2; ++ai)
#pragma unroll
            for (int m = 0; m < 4; ++m) {
                const int rowbase = u.pm * 256 + ai * 128 + wr * 64 + m * 16, row = rowbase + fr;
                const int mb = UNI ? 0 : row_mb(row);
                const float* xin = row < MP ? xp + (size_t)row * 1024 : xs + (size_t)(row - MP) * 1024;
                const float* gp = gmod + mb * 3072 + 2048;
                u32x4 xb[2];
                if (!first) load_pair(XB, 1024, rowbase, fr, colg, xb[0], xb[1]);
                u32x4 PX[2], PA[2];
                float ss = 0.f;
#pragma unroll
                for (int bj = 0; bj < 2; ++bj) {
                    const int c = colg + bj * 32;
                    f32x4 x0, x1;
                    if (first) { x0 = *(const f32x4*)(xin + c); x1 = *(const f32x4*)(xin + c + 4); }
                    else { x0 = (f32x4){bf_lo(xb[bj].x), bf_hi(xb[bj].x), bf_lo(xb[bj].y), bf_hi(xb[bj].y)}; x1 = (f32x4){bf_lo(xb[bj].z), bf_hi(xb[bj].z), bf_lo(xb[bj].w), bf_hi(xb[bj].w)}; }
                    const f32x4 g0 = UNI ? gu[bj][0] : *(const f32x4*)(gp + c), g1 = UNI ? gu[bj][1] : *(const f32x4*)(gp + c + 4);
                    x0 = x0 + g0 * acc[ai][bj][m][0]; x1 = x1 + g1 * acc[ai][bj][m][1];
                    PX[bj] = pack8(x0, x1);
                    ss += (x0.x * x0.x + x0.y * x0.y) + (x0.z * x0.z + x0.w * x0.w) + (x1.x * x1.x + x1.y * x1.y) + (x1.z * x1.z + x1.w * x1.w);
                    PA[bj] = (u32x4){0u, 0u, 0u, 0u};
                    if (ng) {
                        f32x4 a0, a1;
                        if (UNI) { a0 = au[bj][0]; a1 = au[bj][1]; }
                        else { a0 = *(const f32x4*)(ng + c) * (*(const f32x4*)(nmod + mb * 3072 + 1024 + c) + 1.f); a1 = *(const f32x4*)(ng + c + 4) * (*(const f32x4*)(nmod + mb * 3072 + 1024 + c + 4) + 1.f); }
                        PA[bj] = pack8(x0 * a0, x1 * a1);
                    }
                }
                store_pair(XB, 1024, rowbase, fr, colg, PX[0], PX[1]);
                if (ng) store_pair(XA, 1024, rowbase, fr, colg, PA[0], PA[1]);
                ss += __shfl_xor(ss, 16); ss += __shfl_xor(ss, 32);
                if (fq == 0) *(LAS float*)(lds + LDS_RED + ((ai * 128 + wr * 64 + m * 16 + fr) * 4 + wc) * 4) = ss;
            }
    }
};

#define MFMA32(a, b, c) __builtin_amdgcn_mfma_f32_32x32x16_bf16((a), (b), (c), 0, 0, 0)
DI void small_out_tile(LAS unsigned char* lds, int ti, int li, KArgs ka) {
    const int tid = opaque_tid(), lane = tid & 63, w = __builtin_amdgcn_readfirstlane(tid >> 6), hh = lane >> 5, l31 = lane & 31;
    unsigned char* ws = ka->ws;
    const int attn = li & 1, j = li >> 1;
    const bf16_t* A = (const bf16_t*)(ws + WS_B3);
    const bf16_t* Bt = (const bf16_t*)(ws + (attn ? WS_ATTNOUT : WS_POOLOUT)) + (size_t)j * 1048576;
    const int rt = ti >> 4, ct = ti & 15, row0 = MP + rt * 32, col0 = ct * 64, k0 = w * 128;
    const int row = tid >> 4, c4 = (tid & 15) * 4, grow = row0 + row, col = col0 + c4, mb = 32 + rt;
    const float* gmod = (const float*)(ws + WS_MOD) + (size_t)li * NB * 3072;
    bf16_t* XB = (bf16_t*)(ws + WS_XB);
    f32x4 xold = {0.f, 0.f, 0.f, 0.f}; u32x2 xbo = {0u, 0u};
    if (li == 0) xold = *(const f32x4*)(ka->in[1] + (size_t)(grow - MP) * 1024 + col); else xbo = *(const u32x2*)(XB + (size_t)grow * 1024 + col);
    const f32x4 gte = *(const f32x4*)(gmod + mb * 3072 + 2048 + col);
    f32x4 ngv = {0.f, 0.f, 0.f, 0.f}, scv = {0.f, 0.f, 0.f, 0.f};
    if (li < 3) { ngv = *(const f32x4*)(ka->in[7] + (li + 1) * 1024 + col); scv = *(const f32x4*)(gmod + NB * 3072 + mb * 3072 + 1024 + col); }
    bf16x8 af[8], bfr[2][8];
    { const bf16_t* ap = A + (size_t)(row0 + l31) * 1024 + k0 + hh * 8;
#pragma unroll
      for (int sx = 0; sx < 8; ++sx) af[sx] = *(const bf16x8*)(ap + 16 * sx);
#pragma unroll
      for (int nt = 0; nt < 2; ++nt) { const bf16_t* bp = Bt + (size_t)(col0 + nt * 32 + l31) * 1024 + k0 + hh * 8;
#pragma unroll
          for (int sx = 0; sx < 8; ++sx) bfr[nt][sx] = *(const bf16x8*)(bp + 16 * sx); } }
    f32x16 acc[2];
#pragma unroll
    for (int nt = 0; nt < 2; ++nt)
#pragma unroll
        for (int q = 0; q < 16; ++q) acc[nt][q] = 0.f;
#pragma unroll
    for (int sx = 0; sx < 8; ++sx)
#pragma unroll
        for (int nt = 0; nt < 2; ++nt) acc[nt] = MFMA32(af[sx], bfr[nt][sx], acc[nt]);
    LAS float* part = (LAS float*)lds;
    __syncthreads();
#pragma unroll
    for (int nt = 0; nt < 2; ++nt)
#pragma unroll
        for (int q = 0; q < 16; ++q) part[(w * 32 + (q & 3) + 8 * (q >> 2) + 4 * hh) * 64 + nt * 32 + l31] = acc[nt][q];
    __syncthreads();
    f32x4 sum = {0.f, 0.f, 0.f, 0.f};
#pragma unroll
    for (int ww = 0; ww < 8; ++ww) sum = sum + *(const LAS f32x4*)(part + (ww * 32 + row) * 64 + c4);
    f32x4 x = li == 0 ? xold : (f32x4){bf_lo(xbo.x), bf_hi(xbo.x), bf_lo(xbo.y), bf_hi(xbo.y)};
    x = x + gte * sum;
    { u32x2 o; o.x = cvtpk(x.x, x.y); o.y = cvtpk(x.z, x.w); *(u32x2*)(XB + (size_t)grow * 1024 + col) = o; }
    if (li < 3) {
        const f32x4 a = ngv * (scv + 1.f);
        const f32x4 xa = x * a; u32x2 o; o.x = cvtpk(xa.x, xa.y); o.y = cvtpk(xa.z, xa.w); *(u32x2*)((bf16_t*)(ws + WS_XA) + (size_t)grow * 1024 + col) = o;
    }
    float ss = (x.x * x.x + x.y * x.y) + (x.z * x.z + x.w * x.w);
    ss += __shfl_xor(ss, 1); ss += __shfl_xor(ss, 2); ss += __shfl_xor(ss, 4); ss += __shfl_xor(ss, 8);
    if ((tid & 15) == 0) unsafeAtomicAdd((float*)(ws + WS_SSQ) + ((size_t)(li + 1) * R + grow) * 4 + (ct >> 2), ss);
    __syncthreads();
}

DI float wave_sum(float v) {
#pragma unroll
    for (int o = 1; o < 64; o <<= 1) v += __shfl_xor(v, o);
    return v;
}
DI void transpose_item(const float* W, int K, int N, int ldW, bf16_t* WT, int row_off, LAS float* scr, int item, int lane) {
    const int nblk = N / 32, kb = item / nblk, nb = item % nblk, k0 = 64 * kb, n0 = 32 * nb;
    float tv[32];
#pragma unroll
    for (int i = 0; i < 32; ++i) tv[i] = W[(size_t)(k0 + 2 * i + (lane >> 5)) * ldW + n0 + (lane & 31)];
#pragma unroll
    for (int i = 0; i < 32; ++i) scr[(2 * i + (lane >> 5)) * 33 + (lane & 31)] = tv[i];
    asm volatile("s_waitcnt lgkmcnt(0)" ::: "memory");
    const int c = lane & 7;
#pragma unroll
    for (int j = 0; j < 4; ++j) { const int n = (lane >> 3) + 8 * j; const LAS float* s = scr + (8 * c) * 33 + n;
        u32x4 o; o.x = cvtpk(s[0 * 33], s[1 * 33]); o.y = cvtpk(s[2 * 33], s[3 * 33]); o.z = cvtpk(s[4 * 33], s[5 * 33]); o.w = cvtpk(s[6 * 33], s[7 * 33]);
        *(u32x4*)(WT + (size_t)(row_off + n0 + n) * K + k0 + 8 * c) = o; }
    asm volatile("s_waitcnt lgkmcnt(0)" ::: "memory");
}

template <int MODE> DI void gemv48_item(LAS unsigned char* lds, const float* s0, const float* s1, const float* W, int ldW, float* out, int ldo, const float* bias) {
    const int tid = opaque_tid(), lane = tid & 63, w = tid >> 6;
    LAS float* Sk = (LAS float*)lds;
    LAS float* Wc = (LAS float*)(lds + 49152);
    LAS float* part = (LAS float*)lds;
    float acc[48];
#pragma unroll
    for (int b = 0; b < 48; ++b) acc[b] = 0.f;
#pragma unroll 1
    for (int kc = 0; kc < 4; ++kc) {
        float sv[24], wv[32];
#pragma unroll
        for (int i = 0; i < 24; ++i) { const int e = tid + NTHR * i, b = e >> 8, k = kc * 256 + (e & 255);
            sv[i] = MODE == 0 ? (b < 32 ? s0[b * 1024 + k] : s1[(b - 32) * 1024 + k]) : s0[b * 3072 + k]; }
#pragma unroll
        for (int i = 0; i < 32; ++i) { const int e = tid + NTHR * i; wv[i] = W[(size_t)(kc * 256 + (e >> 6)) * ldW + (e & 63)]; }
        __syncthreads();
#pragma unroll
        for (int i = 0; i < 24; ++i) { float v = sv[i]; if (MODE == 0) v = v / (1.f + __expf(-v)); Sk[tid + NTHR * i] = v; }
#pragma unroll
        for (int i = 0; i < 32; ++i) Wc[tid + NTHR * i] = wv[i];
        __syncthreads();
#pragma unroll 2
        for (int k4 = 0; k4 < 8; ++k4) {
            const int kk = w * 32 + 4 * k4;
            const float w0 = Wc[kk * 64 + lane], w1 = Wc[(kk + 1) * 64 + lane], w2 = Wc[(kk + 2) * 64 + lane], w3 = Wc[(kk + 3) * 64 + lane];
#pragma unroll
            for (int b = 0; b < 48; ++b) { const f32x4 sx = *(const LAS f32x4*)(Sk + b * 256 + kk); acc[b] += (sx.x * w0 + sx.y * w1) + (sx.z * w2 + sx.w * w3); }
        }
    }
    __syncthreads();
#pragma unroll
    for (int b = 0; b < 48; ++b) part[(w * 48 + b) * 64 + lane] = acc[b];
    __syncthreads();
    for (int o = tid; o < 48 * 64; o += NTHR) { const int b = o >> 6, l = o & 63; float sum = 0.f;
#pragma unroll
        for (int ww = 0; ww < 8; ++ww) sum += part[(ww * 48 + b) * 64 + l];
        out[(size_t)b * ldo + l] = sum + (bias ? bias[l] : 0.f); }
    __syncthreads();
}

#define MFMA32G(a, b, c) __builtin_amdgcn_mfma_f32_32x32x16_bf16((a), (b), (c), 0, 0, 0)
DI void split_bf16(const float (&x)[8], bf16x8& hi, bf16x8& lo) {
    u32x4 h; h.x = cvtpk(x[0], x[1]); h.y = cvtpk(x[2], x[3]); h.z = cvtpk(x[4], x[5]); h.w = cvtpk(x[6], x[7]);
    u32x4 l; l.x = cvtpk(x[0] - bf_lo(h.x), x[1] - bf_hi(h.x)); l.y = cvtpk(x[2] - bf_lo(h.y), x[3] - bf_hi(h.y)); l.z = cvtpk(x[4] - bf_lo(h.z), x[5] - bf_hi(h.z)); l.w = cvtpk(x[6] - bf_lo(h.w), x[7] - bf_hi(h.w));
    hi = __builtin_bit_cast(bf16x8, h); lo = __builtin_bit_cast(bf16x8, l);
}
template <int MODE> DI void gemv48_mfma(LAS unsigned char* lds, const float* s0, const float* s1, const float* W, int ldW, float* out, int ldo, const float* bias) {
    const int tid = opaque_tid(), lane = tid & 63, w = __builtin_amdgcn_readfirstlane(tid >> 6), hh = lane >> 5, l31 = lane & 31;
    const int k0 = w * 128 + 8 * hh;
    const float* ar0 = MODE == 0 ? s0 + l31 * 1024 : s0 + l31 * 3072;
    const float* ar1 = MODE == 0 ? s1 + (l31 & 15) * 1024 : s0 + (32 + (l31 & 15)) * 3072;
    const bool v1 = l31 < 16;
    const float* wp = W + l31;
    f32x16 acc[2][2];
#pragma unroll
    for (int mt = 0; mt < 2; ++mt)
#pragma unroll
        for (int nt = 0; nt < 2; ++nt)
#pragma unroll
            for (int q = 0; q < 16; ++q) acc[mt][nt][q] = 0.f;
    f32x4 ra[2][2][2]; float rb[2][2][8];
#define GV_ISSUE(buf, sx) do { const int kk = k0 + 16 * (sx); \
        ra[buf][0][0] = *(const f32x4*)(ar0 + kk); ra[buf][0][1] = *(const f32x4*)(ar0 + kk + 4); ra[buf][1][0] = *(const f32x4*)(ar1 + kk); ra[buf][1][1] = *(const f32x4*)(ar1 + kk + 4); \
        _Pragma("unroll") for (int nt = 0; nt < 2; ++nt) _Pragma("unroll") for (int e = 0; e < 8; ++e) rb[buf][nt][e] = wp[(size_t)(kk + e) * ldW + nt * 32]; } while (0)
    GV_ISSUE(0, 0);
#pragma unroll
    for (int sx = 0; sx < 8; ++sx) {
        if (sx + 1 < 8) GV_ISSUE((sx + 1) & 1, sx + 1);
        bf16x8 ahi[2], alo[2], bhi[2], blo[2];
#pragma unroll
        for (int mt = 0; mt < 2; ++mt) {
            float x[8] = {ra[sx & 1][mt][0].x, ra[sx & 1][mt][0].y, ra[sx & 1][mt][0].z, ra[sx & 1][mt][0].w, ra[sx & 1][mt][1].x, ra[sx & 1][mt][1].y, ra[sx & 1][mt][1].z, ra[sx & 1][mt][1].w};
#pragma unroll
            for (int e = 0; e < 8; ++e) { if (MODE == 0) x[e] = x[e] / (1.f + __expf(-x[e])); if (mt == 1 && !v1) x[e] = 0.f; }
            split_bf16(x, ahi[mt], alo[mt]);
        }
#pragma unroll
        for (int nt = 0; nt < 2; ++nt) { float x[8];
#pragma unroll
            for (int e = 0; e < 8; ++e) x[e] = rb[sx & 1][nt][e];
            split_bf16(x, bhi[nt], blo[nt]); }
#pragma unroll
        for (int mt = 0; mt < 2; ++mt)
#pragma unroll
            for (int nt = 0; nt < 2; ++nt) { acc[mt][nt] = MFMA32G(ahi[mt], bhi[nt], acc[mt][nt]); acc[mt][nt] = MFMA32G(ahi[mt], blo[nt], acc[mt][nt]); acc[mt][nt] = MFMA32G(alo[mt], bhi[nt], acc[mt][nt]); }
    }
#undef GV_ISSUE
    LAS float* part = (LAS float*)lds;
    __syncthreads();
#pragma unroll
    for (int mt = 0; mt < 2; ++mt)
#pragma unroll
        for (int nt = 0; nt < 2; ++nt)
#pragma unroll
            for (int q = 0; q < 16; ++q) { const int b = mt * 32 + (q & 3) + 8 * (q >> 2) + 4 * hh; if (mt == 0 || q < 8) part[(w * 48 + b) * 64 + nt * 32 + l31] = acc[mt][nt][q]; }
    __syncthreads();
    for (int o = tid; o < 48 * 64; o += NTHR) { const int b = o >> 6, l = o & 63; float sum = 0.f;
#pragma unroll
        for (int ww = 0; ww < 8; ++ww) sum += part[(ww * 48 + b) * 64 + l];
        out[(size_t)b * ldo + l] = sum + (bias ? bias[l] : 0.f); }
    __syncthreads();
}

DI void blkdiag_item(LAS unsigned char* lds, const float* src, int ldsrc, int nrows, const float* Gm, float* out, int ch) {
    const int tid = opaque_tid();
    LAS float* sm = (LAS float*)lds;
    __syncthreads();
    for (int e = tid; e < 16 * 256; e += NTHR) { const int r = e >> 8, c4 = e & 255; f32x4 v = {0.f, 0.f, 0.f, 0.f}; if (r < nrows) v = *(const f32x4*)(src + (size_t)r * ldsrc + c4 * 4); *(LAS f32x4*)(sm + r * 1024 + c4 * 4) = v; }
    __syncthreads();
    const int c = ch * 512 + tid, g = c >> 8, cc = c & 255;
    const float* gp = Gm + (size_t)g * 65536 + cc;
    float acc[16];
#pragma unroll
    for (int r = 0; r < 16; ++r) acc[r] = 0.f;
#pragma unroll 1
    for (int i = 0; i < 256; i += 16) {
        float gv[16];
#pragma unroll
        for (int q = 0; q < 16; ++q) gv[q] = gp[(i + q) * 256];
#pragma unroll
        for (int q = 0; q < 16; q += 4)
#pragma unroll
            for (int r = 0; r < 16; ++r) { const f32x4 sx = *(const LAS f32x4*)(sm + r * 1024 + g * 256 + i + q); acc[r] += (sx.x * gv[q] + sx.y * gv[q + 1]) + (sx.z * gv[q + 2] + sx.w * gv[q + 3]); }
    }
#pragma unroll
    for (int r = 0; r < 16; ++r) if (r < nrows) out[(size_t)r * 1024 + c] = acc[r];
}

DI void blkdiag_mfma(const float* src, int ldsrc, int nrows, const float* Gm, float* out, int ch) {
    const int tid = opaque_tid(), lane = tid & 63, w = __builtin_amdgcn_readfirstlane(tid >> 6), hh = lane >> 5, l31 = lane & 31;
    const int c0 = ch * 512 + w * 64, g = c0 >> 8, cc0 = c0 & 255;
    const bool va = l31 < nrows;
    const float* ar = src + (size_t)(va ? l31 : 0) * ldsrc + g * 256 + 8 * hh;
    const float* bp = Gm + (size_t)g * 65536 + (size_t)(8 * hh) * 256 + cc0 + l31;
    f32x16 acc[2];
#pragma unroll
    for (int nt = 0; nt < 2; ++nt)
#pragma unroll
        for (int q = 0; q < 16; ++q) acc[nt][q] = 0.f;
    f32x4 ra[2][2]; float rb[2][2][8];
#define BD_ISSUE(buf, sx) do { ra[buf][0] = *(const f32x4*)(ar + 16 * (sx)); ra[buf][1] = *(const f32x4*)(ar + 16 * (sx) + 4); \
        _Pragma("unroll") for (int nt = 0; nt < 2; ++nt) _Pragma("unroll") for (int e = 0; e < 8; ++e) rb[buf][nt][e] = bp[(size_t)(16 * (sx) + e) * 256 + nt * 32]; } while (0)
    BD_ISSUE(0, 0);
#pragma unroll
    for (int sx = 0; sx < 16; ++sx) {
        if (sx + 1 < 16) BD_ISSUE((sx + 1) & 1, sx + 1);
        bf16x8 ahi, alo, bhi[2], blo[2];
        { float x[8] = {ra[sx & 1][0].x, ra[sx & 1][0].y, ra[sx & 1][0].z, ra[sx & 1][0].w, ra[sx & 1][1].x, ra[sx & 1][1].y, ra[sx & 1][1].z, ra[sx & 1][1].w};
#pragma unroll
          for (int e = 0; e < 8; ++e) if (!va) x[e] = 0.f;
          split_bf16(x, ahi, alo); }
#pragma unroll
        for (int nt = 0; nt < 2; ++nt) { float x[8];
#pragma unroll
            for (int e = 0; e < 8; ++e) x[e] = rb[sx & 1][nt][e];
            split_bf16(x, bhi[nt], blo[nt]); }
#pragma unroll
        for (int nt = 0; nt < 2; ++nt) { acc[nt] = MFMA32G(ahi, bhi[nt], acc[nt]); acc[nt] = MFMA32G(ahi, blo[nt], acc[nt]); acc[nt] = MFMA32G(alo, bhi[nt], acc[nt]); }
    }
#undef BD_ISSUE
#pragma unroll
    for (int nt = 0; nt < 2; ++nt)
#pragma unroll
        for (int q = 0; q < 8; ++q) { const int m = (q & 3) + 8 * (q >> 2) + 4 * hh; if (m < nrows) out[(size_t)m * 1024 + c0 + nt * 32 + l31] = acc[nt][q]; }
}

#undef MFMA32
constexpr int KPITCH = 72, VPITCH = 96  , LDS_VT = 192 * KPITCH * 2, RPITCH = 264  , LDS_QS = LDS_VT + 192 * VPITCH * 2, LDS_SS = LDS_QS + 64 * RPITCH * 2;
static_assert(LDS_SS + 64 * RPITCH * 2 <= LDS_MISC, "attention LDS map");
typedef short v4i16_t __attribute__((ext_vector_type(4)));
#define MFMA32(a, b, c) __builtin_amdgcn_mfma_f32_32x32x16_bf16((a), (b), (c), 0, 0, 0)
template <bool STAGED> DI void attn_compute(const LAS bf16_t* Ks, const LAS bf16_t* Vt, const bf16x8 (&qf)[4], int nkt, int dq0, int qi, int hh, int l31, int head, const float* sinks, const bf16_t* sgp, bf16_t* op, LAS bf16_t* sgl) {
    const int lane = hh * 32 + l31;
    u32x2 sgv[2][4];
#pragma unroll
    for (int mt = 0; mt < 2; ++mt)
#pragma unroll
        for (int jj = 0; jj < 4; ++jj) { sgv[mt][jj] = (u32x2){0u, 0u}; if (!STAGED) sgv[mt][jj] = *(const u32x2*)(sgp + mt * 32 + 8 * jj + 4 * hh); }
    f32x16 st[6];
#pragma unroll
    for (int kt = 0; kt < 6; ++kt) {
#pragma unroll
        for (int j = 0; j < 16; ++j) st[kt][j] = 0.f;
        if (kt < nkt) {
#pragma unroll
            for (int ks = 0; ks < 4; ++ks) { const bf16x8 a = *(const LAS bf16x8*)(Ks + (kt * 32 + l31) * KPITCH + ks * 16 + hh * 8); st[kt] = MFMA32(a, qf[ks], st[kt]); }
        }
    }
    const float slope2 = exp2f(-0.5f * (float)(head + 1)) * LOG2E;
    const float sink2 = sinks[head] * LOG2E;
    float dqf = (float)(dq0 + qi - 4 * hh); asm volatile("" : "+v"(dqf));
    float mx = sink2;
#pragma unroll
    for (int kt = 0; kt < 6; ++kt) if (kt < nkt) {
#pragma unroll
        for (int j = 0; j < 16; ++j) { const float kc = (float)(kt * 32 + (j & 3) + 8 * (j >> 2)); const float sv = st[kt][j] - slope2 * fabsf(dqf - kc); st[kt][j] = sv; mx = fmaxf(mx, sv); }
    }
    mx = fmaxf(mx, __shfl_xor(mx, 32));
    float sum = 0.f;
#pragma unroll
    for (int kt = 0; kt < 6; ++kt) if (kt < nkt) {
#pragma unroll
        for (int j = 0; j < 16; ++j) { const float pe = __builtin_amdgcn_exp2f(st[kt][j] - mx); st[kt][j] = pe; sum += pe; }
    }
    sum += __shfl_xor(sum, 32);
    const float inv = 1.f / (sum + __builtin_amdgcn_exp2f(sink2 - mx));
    f32x16 ot[2];
#pragma unroll
    for (int mt = 0; mt < 2; ++mt)
#pragma unroll
        for (int j = 0; j < 16; ++j) ot[mt][j] = 0.f;
#pragma unroll
    for (int kt = 0; kt < 6; ++kt) if (kt < nkt) {
#pragma unroll
        for (int sx = 0; sx < 2; ++sx) {
            u32x4 pw; pw.x = cvtpk(st[kt][8 * sx], st[kt][8 * sx + 1]); pw.y = cvtpk(st[kt][8 * sx + 2], st[kt][8 * sx + 3]); pw.z = cvtpk(st[kt][8 * sx + 4], st[kt][8 * sx + 5]); pw.w = cvtpk(st[kt][8 * sx + 6], st[kt][8 * sx + 7]);
            const bf16x8 pb = __builtin_bit_cast(bf16x8, pw);
#pragma unroll
            for (int mt = 0; mt < 2; ++mt) {
                const LAS bf16_t* vp = Vt + (kt * 32 + 16 * sx + 4 * hh + ((lane >> 2) & 3)) * VPITCH + mt * 32 + ((lane >> 4) & 1) * 16 + (lane & 3) * 4;
                const s16x4 lo = __builtin_bit_cast(s16x4, __builtin_amdgcn_ds_read_tr16_b64_v4i16((LAS v4i16_t*)vp)), hi = __builtin_bit_cast(s16x4, __builtin_amdgcn_ds_read_tr16_b64_v4i16((LAS v4i16_t*)(vp + 8 * VPITCH)));
                const bf16x8 a = {lo[0], lo[1], lo[2], lo[3], hi[0], hi[1], hi[2], hi[3]};
                ot[mt] = MFMA32(a, pb, ot[mt]);
            }
        }
    }
#pragma unroll
    for (int mt = 0; mt < 2; ++mt)
#pragma unroll
        for (int jj = 0; jj < 4; ++jj) {
            const int d0 = mt * 32 + 8 * jj + 4 * hh;
            u32x2 sg; if (STAGED) sg = *(const LAS u32x2*)(sgl + d0); else sg = sgv[mt][jj];
            u32x2 o; o.x = cvtpk(ot[mt][4 * jj] * inv * bf_lo(sg.x), ot[mt][4 * jj + 1] * inv * bf_hi(sg.x)); o.y = cvtpk(ot[mt][4 * jj + 2] * inv * bf_lo(sg.y), ot[mt][4 * jj + 3] * inv * bf_hi(sg.y));
            if (STAGED) *(LAS u32x2*)(sgl + d0) = o; else *(u32x2*)(op + d0) = o;
        }
}
DI void attn_decode(int item0, int rev, int& kvh, int& nkeys, int& qrow0, int& krow0, int& dq0) {
    const int item = rev ? 4095 - item0 : item0;
    kvh = item & 3; const int n = (item >> 2) & 31, b = item >> 7, nk = (n < 2 ? n : 2) + 1; nkeys = nk * 64; krow0 = b * 2048 + (n - nk + 1) * 64; qrow0 = b * 2048 + n * 64; dq0 = (nk - 1) * 64;
}
DI void attn_issue(int item, int rev, const bf16_t* KB, const bf16_t* VB, const bf16_t* Q, const bf16_t* SG, int tid, int lane, int w, u32x4 (&kr)[3], u32x4 (&vr)[3], u32x4 (&qr)[4], u32x4 (&sr)[4]) {
    int kvh, nkeys, qrow0, krow0, dq0; attn_decode(item, rev, kvh, nkeys, qrow0, krow0, dq0);
#pragma unroll
    for (int i = 0; i < 3; ++i) {
        const int pk = tid + NTHR * i;
        if (pk < nkeys * 8) kr[i] = *(const u32x4*)(KB + (size_t)(krow0 + (pk >> 3)) * 256 + kvh * 64 + (pk & 7) * 8);
        if (pk < nkeys * 8) vr[i] = *(const u32x4*)(VB + (size_t)(krow0 + (pk >> 3)) * 256 + kvh * 64 + (pk & 7) * 8);
    }
#pragma unroll
    for (int i = 0; i < 4; ++i) {
        const int pp = tid + NTHR * i; const size_t o = (size_t)(qrow0 + (pp >> 5)) * 1024 + kvh * 256 + (pp & 31) * 8;
        qr[i] = *(const u32x4*)(Q + o); sr[i] = *(const u32x4*)(SG + o);
    }
}
DI void attn_phase(LAS unsigned char* lds, const bf16_t* Q, const bf16_t* KB, const bf16_t* VB, const bf16_t* SG, bf16_t* OG, const float* ck, const float* cv, const float* sinks, int G, int bid, int rev) {
    const int tid = opaque_tid(), lane = tid & 63, w = __builtin_amdgcn_readfirstlane(tid >> 6), hh = lane >> 5, l31 = lane & 31;
    LAS bf16_t* Ks = (LAS bf16_t*)lds; LAS bf16_t* Vt = (LAS bf16_t*)(lds + LDS_VT);
    const int g = w >> 1, qhalf = w & 1, qi = qhalf * 32 + l31;
    LAS bf16_t* Qs = (LAS bf16_t*)(lds + LDS_QS); LAS bf16_t* Ss = (LAS bf16_t*)(lds + LDS_SS);
    u32x4 kr[3], vr[3], qr[4], sr[4];
#pragma unroll
    for (int i = 0; i < 3; ++i) { kr[i] = (u32x4){0u, 0u, 0u, 0u}; vr[i] = (u32x4){0u, 0u, 0u, 0u}; }
#pragma unroll
    for (int i = 0; i < 4; ++i) { qr[i] = (u32x4){0u, 0u, 0u, 0u}; sr[i] = (u32x4){0u, 0u, 0u, 0u}; }
    if (bid < 4096) attn_issue(bid, rev, KB, VB, Q, SG, tid, lane, w, kr, vr, qr, sr);
    for (int item = bid; item < 4096; item += G) {
        int kvh, nkeys, qrow0, krow0, dq0; attn_decode(item, rev, kvh, nkeys, qrow0, krow0, dq0);
        __syncthreads();
#pragma unroll
        for (int i = 0; i < 3; ++i) {
            const int pk = tid + NTHR * i;
            if (pk < nkeys * 8) { *(LAS u32x4*)(Ks + (pk >> 3) * KPITCH + (pk & 7) * 8) = kr[i]; *(LAS u32x4*)(Vt + (pk >> 3) * VPITCH + (pk & 7) * 8) = vr[i]; }
        }
#pragma unroll
        for (int i = 0; i < 4; ++i) { const int pp = tid + NTHR * i; *(LAS u32x4*)(Qs + (pp >> 5) * RPITCH + (pp & 31) * 8) = qr[i]; *(LAS u32x4*)(Ss + (pp >> 5) * RPITCH + (pp & 31) * 8) = sr[i]; }
        if (item + G < 4096) attn_issue(item + G, rev, KB, VB, Q, SG, tid, lane, w, kr, vr, qr, sr);
        __syncthreads();
        const int head = kvh * 4 + g;
        bf16x8 qf[4];
#pragma unroll
        for (int ks = 0; ks < 4; ++ks) qf[ks] = *(const LAS bf16x8*)(Qs + qi * RPITCH + g * 64 + ks * 16 + hh * 8);
        attn_compute<true>(Ks, Vt, qf, nkeys >> 5, dq0, qi, hh, l31, head, sinks, nullptr, nullptr, Ss + qi * RPITCH + g * 64);
        __syncthreads();
#pragma unroll
        for (int i = 0; i < 4; ++i) { const int pp = tid + NTHR * i; *(u32x4*)(OG + (size_t)(qrow0 + (pp >> 5)) * 1024 + kvh * 256 + (pp & 31) * 8) = *(const LAS u32x4*)(Ss + (pp >> 5) * RPITCH + (pp & 31) * 8); }
    }
    int e_lo = bid, e_hi = 64, e_st = G;
    if (G == 256) { const int ncls = (bid >> 2) & 31, neff = rev ? 31 - ncls : ncls, idx = (bid & 3) + 4 * (bid >> 7);
        e_st = 1; if (neff == 0) { e_lo = idx * 7; e_hi = e_lo + 7; } else if (neff == 1) { e_lo = 56 + idx; e_hi = e_lo + 1; } else { e_lo = 0; e_hi = 0; } }
    for (int e = e_lo; e < e_hi; e += e_st) {
        const int kvh = e & 3, sb = e >> 2, nkeys = 160, krow0 = MP + sb * 32 - 128, qrow0 = MP + sb * 32, dq0 = 128;
        __syncthreads();
        for (int pk = tid; pk < nkeys * 8; pk += NTHR) {
            const int key = pk >> 3, seg = pk & 7;
            u32x4 kk, vv;
            if (key < 128) { const size_t o = ((size_t)(sb * 128 + key) * 4 + kvh) * 64 + seg * 8;
                kk = pack8(*(const f32x4*)(ck + o), *(const f32x4*)(ck + o + 4)); vv = pack8(*(const f32x4*)(cv + o), *(const f32x4*)(cv + o + 4)); }
            else { const size_t o = (size_t)(krow0 + key) * 256 + kvh * 64 + seg * 8; kk = *(const u32x4*)(KB + o); vv = *(const u32x4*)(VB + o); }
            *(LAS u32x4*)(Ks + key * KPITCH + seg * 8) = kk;
            *(LAS u32x4*)(Vt + key * VPITCH + seg * 8) = vv;
        }
        const int head = kvh * 4 + g; const bool active = !qhalf; const size_t qrow = (size_t)(qrow0 + l31);
        bf16x8 qf[4];
#pragma unroll
        for (int ks = 0; ks < 4; ++ks) qf[ks] = (bf16x8){0, 0, 0, 0, 0, 0, 0, 0};
        if (active) {
#pragma unroll
            for (int ks = 0; ks < 4; ++ks) qf[ks] = *(const bf16x8*)(Q + qrow * 1024 + head * 64 + ks * 16 + hh * 8);
        }
        __syncthreads();
        if (active) attn_compute<false>(Ks, Vt, qf, nkeys >> 5, dq0, l31, hh, l31, head, sinks, SG + qrow * 1024 + head * 64, OG + qrow * 1024 + head * 64, nullptr);
    }
    __syncthreads();
}

template <int W> DI void pool_item(const bf16_t* V1, const bf16_t* SG, bf16_t* ZG, size_t rowb, int t0, int c0, const float (&sc)[8]) {
    constexpr int NR = 8;
    u32x4 vr[W - 1 + NR], sgr[NR];
#pragma unroll
    for (int i = 0; i < W - 1 + NR; ++i) { const int t = t0 - (W - 1) + i; vr[i] = (u32x4){0u, 0u, 0u, 0u}; if (t >= 0) vr[i] = *(const u32x4*)(V1 + (rowb + t) * 1024 + c0); }
#pragma unroll
    for (int i = 0; i < NR; ++i) sgr[i] = *(const u32x4*)(SG + (rowb + t0 + i) * 1024 + c0);
    float S[8];
#pragma unroll
    for (int e = 0; e < 8; ++e) S[e] = 0.f;
#pragma unroll
    for (int i = 0; i < W - 1; ++i) { float f[8]; unpack8(vr[i], f);
#pragma unroll
        for (int e = 0; e < 8; ++e) S[e] += f[e]; }
#pragma unroll
    for (int tt = 0; tt < NR; ++tt) {
        float cur[8], sg[8], old[8], z[8];
        unpack8(vr[W - 1 + tt], cur); unpack8(sgr[tt], sg); unpack8(vr[tt], old);
#pragma unroll
        for (int e = 0; e < 8; ++e) sg[e] = silu_f(sg[e]);
        const int t = t0 + tt; const float rn = 1.f / (float)(t + 1 < W ? t + 1 : W);
#pragma unroll
        for (int e = 0; e < 8; ++e) { S[e] += cur[e]; z[e] = (S[e] * rn - cur[e]) * sc[e] * sg[e]; S[e] -= old[e]; }
        u32x4 o; o.x = cvtpk(z[0], z[1]); o.y = cvtpk(z[2], z[3]); o.z = cvtpk(z[4], z[5]); o.w = cvtpk(z[6], z[7]);
        *(u32x4*)(ZG + (rowb + t) * 1024 + c0) = o;
    }
}
DI void pool_phase(const bf16_t* V1, const bf16_t* SG, bf16_t* ZG, const float* pscale, const float* hv, int G, int bid, int rev) {
    const int tid = opaque_tid(), lane = tid & 63, wave = __builtin_amdgcn_readfirstlane(tid >> 6);
    const int g = wave & 3, sub = (wave >> 2) * 2 + (lane >> 5), c0 = g * 256 + (lane & 31) * 8, w = 2 << g;
    float sc[8];
    { const f32x4 a = *(const f32x4*)(pscale + c0), b = *(const f32x4*)(pscale + c0 + 4); sc[0] = a.x; sc[1] = a.y; sc[2] = a.z; sc[3] = a.w; sc[4] = b.x; sc[5] = b.y; sc[6] = b.z; sc[7] = b.w; }
    for (int it0 = bid; it0 < 2048; it0 += G) {
        const int item = rev ? 2047 - it0 : it0;
        const size_t rowb = (size_t)(item >> 6) * 2048; const int t0 = (item & 63) * 32 + sub * 8;
        if (g == 0) pool_item<2>(V1, SG, ZG, rowb, t0, c0, sc); else if (g == 1) pool_item<4>(V1, SG, ZG, rowb, t0, c0, sc);
        else if (g == 2) pool_item<8>(V1, SG, ZG, rowb, t0, c0, sc); else pool_item<16>(V1, SG, ZG, rowb, t0, c0, sc);
    }
    for (int sb = bid; sb < 16; sb += G) {
        const size_t rowb = (size_t)MP + sb * 32;
        const float rn = 1.f / (float)w;
        for (int t = sub * 8; t < sub * 8 + 8; ++t) {
            float S[8];
#pragma unroll
            for (int e = 0; e < 8; ++e) S[e] = 0.f;
            for (int j = 0; j < w; ++j) { const int te = t - j; float f[8];
                if (te >= 0) unpack8(*(const u32x4*)(V1 + (rowb + te) * 1024 + c0), f);
                else { const float* hp = hv + ((size_t)sb * 15 + 15 + te) * 1024 + c0; const f32x4 a = *(const f32x4*)hp, b2 = *(const f32x4*)(hp + 4); f[0] = a.x; f[1] = a.y; f[2] = a.z; f[3] = a.w; f[4] = b2.x; f[5] = b2.y; f[6] = b2.z; f[7] = b2.w; }
#pragma unroll
                for (int e = 0; e < 8; ++e) S[e] += f[e]; }
            float cur[8], sg[8], z[8];
            unpack8(*(const u32x4*)(V1 + (rowb + t) * 1024 + c0), cur); unpack8(*(const u32x4*)(SG + (rowb + t) * 1024 + c0), sg);
#pragma unroll
            for (int e = 0; e < 8; ++e) z[e] = (S[e] * rn - cur[e]) * sc[e] * silu_f(sg[e]);
            u32x4 o; o.x = cvtpk(z[0], z[1]); o.y = cvtpk(z[2], z[3]); o.z = cvtpk(z[4], z[5]); o.w = cvtpk(z[6], z[7]);
            *(u32x4*)(ZG + (rowb + t) * 1024 + c0) = o;
        }
    }
}

#define RLX_AGENT __ATOMIC_RELAXED, __HIP_MEMORY_SCOPE_AGENT
#define XB_TMO      128
#define XB_XCNT(j)  (256  + 64 * (j))
#define XB_XSUB(j)  (1280 + 64 * (j))
#define XB_XGEN(j)  (2304 + 64 * (j))
#define XB_TOP      3328
#define XB_TOPGEN   3392
#define XCD_BAR_WORDS 3456
#define XB_SPIN_CAP (1u << 18)

__device__ __forceinline__ unsigned xb_ld(unsigned* p)              { return __hip_atomic_load(p, __ATOMIC_RELAXED, __HIP_MEMORY_SCOPE_AGENT); }
__device__ __forceinline__ unsigned xb_add(unsigned* p, unsigned v) { return __hip_atomic_fetch_add(p, v, __ATOMIC_RELAXED, __HIP_MEMORY_SCOPE_AGENT); }
__device__ __forceinline__ unsigned xb_xcc_id() { return (unsigned)__builtin_amdgcn_s_getreg((3 << 11) | 20) & 0xFu; }
#define XB_SPIN(cond, bar) do { unsigned _sp = 0; while (cond) { __builtin_amdgcn_s_sleep(1); \
    if ((++_sp & 255u) == 0u) { if (xb_ld(&(bar)[XB_TMO])) break; if (_sp > XB_SPIN_CAP) { atomicAdd(&(bar)[XB_TMO], 1u); break; } } } } while (0)

struct XcdBarrier {
    unsigned* bar; unsigned x;
    volatile LAS unsigned* st;
};

__device__ __forceinline__ XcdBarrier xcd_barrier_post(unsigned* bar, volatile LAS unsigned* st) {
    XcdBarrier b; b.bar = bar; b.x = xb_xcc_id(); b.st = st;
    if (threadIdx.x == 0) (void)xb_add(&bar[XB_XCNT(b.x)], 1u);
    return b;
}
__device__ __forceinline__ void xcd_barrier_complete(unsigned* bar, unsigned x, unsigned& nloc, unsigned& nx) {
    const unsigned G = gridDim.x * gridDim.y * gridDim.z;
    unsigned sum, cnt, mine, sp = 0u;
    for (;;) {
        sum = 0u; cnt = 0u; mine = 0u;
#pragma unroll
        for (unsigned j = 0; j < 16; ++j) { const unsigned c = xb_ld(&bar[XB_XCNT(j)]); sum += c; cnt += (c > 0u) ? 1u : 0u; mine = (j == x) ? c : mine; }
        if (sum == G) break;
        __builtin_amdgcn_s_sleep(1);
        if ((++sp & 255u) == 0u) { if (xb_ld(&bar[XB_TMO])) break; if (sp > XB_SPIN_CAP) { atomicAdd(&bar[XB_TMO], 1u); break; } }
    }
    nloc = mine > 0u ? mine : 1u; nx = cnt > 0u ? cnt : 1u;
}

__device__ __forceinline__ void xcd_barrier(const XcdBarrier& b) {
    asm volatile("s_waitcnt vmcnt(0)" ::: "memory");
    __syncthreads();
    if (threadIdx.x == 0) {
        unsigned* bar = b.bar;
        __builtin_amdgcn_s_waitcnt(0);
        unsigned nloc = b.st[0], nx = b.st[1];
        if (nloc == 0u) { xcd_barrier_complete(bar, b.x, nloc, nx); b.st[0] = nloc; b.st[1] = nx; }
        const unsigned old = xb_add(&bar[XB_XSUB(b.x)], 1u);
        const unsigned gen = old / nloc;
        if (old + 1u == (gen + 1u) * nloc) {
            __builtin_amdgcn_fence(__ATOMIC_RELEASE, "agent");
            asm volatile("s_waitcnt vmcnt(0)" ::: "memory");
            const unsigned og = xb_add(&bar[XB_TOP], 1u);
            const unsigned tg = og / nx;
            if (og + 1u == (tg + 1u) * nx) xb_add(&bar[XB_TOPGEN], 1u);
            else XB_SPIN(xb_ld(&bar[XB_TOPGEN]) == tg, bar);
            __builtin_amdgcn_fence(__ATOMIC_ACQUIRE, "agent");
            xb_add(&bar[XB_XGEN(b.x)], 1u);
            asm volatile("s_waitcnt vmcnt(0)" ::: "memory");
        } else {
            XB_SPIN(xb_ld(&bar[XB_XGEN(b.x)]) == gen, bar);
            __builtin_amdgcn_fence(__ATOMIC_ACQUIRE, "agent");
            asm volatile("s_waitcnt vmcnt(0)" ::: "memory");
        }
    }
    __syncthreads();
}

constexpr int N_PHASES = 15;

__global__ void __launch_bounds__(NTHR, 2) mk_fwd(Args args) {
    extern __shared__ __attribute__((aligned(16))) unsigned char lds_raw[];
    LAS unsigned char* lds = (LAS unsigned char*)lds_raw;
    cg::grid_group grid = cg::this_grid();
    KArgs ka = (KArgs)__builtin_amdgcn_kernarg_segment_ptr();
    if (threadIdx.x < 2) ((LAS unsigned*)(lds + LDS_MISC))[threadIdx.x] = 0u;
    __syncthreads();
#ifndef USE_XBAR
#define USE_XBAR 1
#endif
#ifndef HOST_ZERO_BAR
#define HOST_ZERO_BAR 1
#endif
    XcdBarrier xbar; xbar.bar = nullptr; xbar.x = 0; xbar.st = (volatile LAS unsigned*)(lds + LDS_MISC);
    if (HOST_ZERO_BAR && USE_XBAR && ka->ph_hi - ka->ph_lo > 1) xbar = xcd_barrier_post((unsigned*)(ka->ws + WS_BAR), (volatile LAS unsigned*)(lds + LDS_MISC));
    const int ph_hi = ka->ph_hi;
#define IN_(i) ((const float*)ka->in[i])
#define x_prompt IN_(0)
#define x_sample IN_(1)
#define c_prompt IN_(2)
#define c_sample IN_(3)
#define cache_pool IN_(4)
#define cache_k IN_(5)
#define cache_v IN_(6)
#define norm_g IN_(7)
#define ada_w IN_(8)
#define ada_b IN_(9)
#define pool_w_in IN_(10)
#define pool_w_grp IN_(11)
#define pool_scale IN_(12)
#define pool_w_out IN_(13)
#define attn_w_in IN_(14)
#define attn_sinks IN_(15)
#define attn_w_out IN_(16)
#define final_g IN_(17)
#define out ((float*)ka->out)
#define ws ((unsigned char*)ka->ws)
#define ssq ((float*)(ws + WS_SSQ))
#define mod ((float*)(ws + WS_MOD))
#define biasv ((float*)(ws + WS_BIAS))
#define Wp ((float*)(ws + WS_WP))
#define hv ((float*)(ws + WS_HV))
#define poolBt ((bf16_t*)(ws + WS_POOLBT))
#define attnBt ((bf16_t*)(ws + WS_ATTNBT))
#define poolOutBt ((bf16_t*)(ws + WS_POOLOUT))
#define attnOutBt ((bf16_t*)(ws + WS_ATTNOUT))
#define XA ((bf16_t*)(ws + WS_XA))
#define B1 ((bf16_t*)(ws + WS_B1))
#define B2 ((bf16_t*)(ws + WS_B2))
#define B3 ((bf16_t*)(ws + WS_B3))
#define KBuf ((bf16_t*)(ws + WS_KB))
#define VBuf ((bf16_t*)(ws + WS_VB))
    for (int ph = ka->ph_lo; ph < ph_hi; ++ph) {
#ifndef DUP_MASK
#define DUP_MASK 0
#endif
        const int dupk = ph == 4 ? 5 : ph < 2 ? 0 : (ph == N_PHASES - 1 ? 3 : ((ph - 2) % 3 == 1 ? ((((ph - 2) / 3) & 1) ? 4 : 1) : ((ph - 2) % 3 == 0 ? 2 : 3)));
        const int nrep = 1 + ((DUP_MASK >> dupk) & 1);
        for (int rep = 0; rep < nrep; ++rep) {
        int G, bid; asm volatile("s_mov_b32 %0, %2\n\ts_mov_b32 %1, %3" : "=s"(G), "=s"(bid) : "s"((int)gridDim.x), "s"((int)blockIdx.x));
        const int tid = opaque_tid(), lane = tid & 63, wave = __builtin_amdgcn_readfirstlane(tid >> 6);
        const int gw = bid * NWAVES + wave, NGW = G * NWAVES;
#ifndef USE_REV
#define USE_REV 1
#endif
        const int PH_REV = USE_REV ? ((ph + 1) & 1) : 0;
        if (ph == 0) {
            if (!HOST_ZERO_BAR && bid == 0) for (int i = tid; i < XCD_BAR_WORDS; i += NTHR) ((unsigned*)(ws + WS_BAR))[i] = 0u;
            if (SMALL_OUT) for (int i = bid * NTHR + tid; i < 4 * 2048; i += G * NTHR) ssq[((size_t)((i >> 11) + 1) * R + MP) * 4 + (i & 2047)] = 0.f;
            for (int i = bid * NTHR + tid; i < 2 * 16 * 96 * 64; i += G * NTHR) { const int c4 = i & 63, r = (i >> 6) % 96, jsb = i / (64 * 96);
                const size_t so = ((size_t)jsb * 128 + 32 + r) * 256 + c4 * 4, dofs = ((size_t)jsb * 128 + r) * 256 + c4 * 4;
                *(f32x4*)(out + OFF_KS + dofs) = *(const f32x4*)(cache_k + so); *(f32x4*)(out + OFF_VS + dofs) = *(const f32x4*)(cache_v + so); }
            for (int it = bid; it < 192; it += G) { const int i = it / 48, ch = it % 48;
                gemv48_mfma<0>(lds, c_prompt, c_sample, ada_w + (size_t)i * 1024 * 3072 + ch * 64, 3072, mod + (size_t)i * NB * 3072 + ch * 64, 3072, ada_b + i * 3072 + ch * 64); }
            for (int it = (bid + 64) % G; it < 320; it += G) {
                if (it < 256) { const int j = it >> 7, kb = (it >> 1) & 63, ch = it & 1;
                    blkdiag_mfma(pool_w_in + (size_t)j * 1024 * 2048 + (size_t)kb * 16 * 2048, 2048, 16, pool_w_grp + (size_t)j * 4 * 65536, Wp + (size_t)j * 1048576 + (size_t)kb * 16 * 1024, ch); }
                else { const int e = it - 256, j = e >> 5, sb = (e >> 1) & 15, ch = e & 1;
                    blkdiag_mfma(cache_pool + ((size_t)j * 16 + sb) * 15 * 1024, 1024, 15, pool_w_grp + (size_t)j * 4 * 65536, hv + ((size_t)j * 16 + sb) * 15 * 1024, ch); }
            }
            __syncthreads();
            LAS float* scr = (LAS float*)(lds + wave * 16384);
            for (int it = gw; it < 2 * 3328; it += NGW) { const int j = it / 3328; int r = it % 3328;
                if (r < 1280) { transpose_item(attn_w_in + (size_t)j * 1024 * 2560, 1024, 2560, 2560, attnBt + (size_t)j * 2560 * 1024, 0, scr, r, lane); continue; } r -= 1280;
                if (r < 512) { transpose_item(attn_w_out + (size_t)j * 1048576, 1024, 1024, 1024, attnOutBt + (size_t)j * 1048576, 0, scr, r, lane); continue; } r -= 512;
                if (r < 512) { transpose_item(pool_w_out + (size_t)j * 1048576, 1024, 1024, 1024, poolOutBt + (size_t)j * 1048576, 0, scr, r, lane); continue; } r -= 512;
                if (r < 512) { transpose_item(pool_w_in + (size_t)j * 1024 * 2048 + 1024, 1024, 1024, 2048, poolBt + (size_t)j * 3072 * 1024, 1024, scr, r, lane); continue; } r -= 512;
                transpose_item(pool_w_in + (size_t)j * 1024 * 2048, 1024, 1024, 2048, poolBt + (size_t)j * 3072 * 1024, 2048, scr, r, lane); }
        } else if (ph == 1) {
            for (int it = bid; it < 176; it += G) {
                if (it < 96) { const int j = it / 48, ch = it % 48; const float* W; int ldW;
                    if (ch < 16) { W = Wp + (size_t)j * 1048576 + ch * 64; ldW = 1024; } else if (ch < 32) { W = pool_w_in + (size_t)j * 1024 * 2048 + 1024 + (ch - 16) * 64; ldW = 2048; } else { W = pool_w_in + (size_t)j * 1024 * 2048 + (ch - 32) * 64; ldW = 2048; }
                    gemv48_mfma<1>(lds, mod + (size_t)(2 * j) * NB * 3072, nullptr, W, ldW, biasv + (size_t)(2 * j) * NB * 3072 + ch * 64, 3072, nullptr); }
                else { const int e = it - 96, j = e / 40, ch = e % 40;
                    gemv48_mfma<1>(lds, mod + (size_t)(2 * j + 1) * NB * 3072, nullptr, attn_w_in + (size_t)j * 1024 * 2560 + ch * 64, 2560, biasv + (size_t)(2 * j + 1) * NB * 3072 + ch * 64, 3072, nullptr); }
            }
            __syncthreads();
            LAS float* scr = (LAS float*)(lds + wave * 16384);
            for (int it = gw; it < 1024; it += NGW) { const int j = it >> 9; transpose_item(Wp + (size_t)j * 1048576, 1024, 1024, 1024, poolBt + (size_t)j * 3072 * 1024, 0, scr, it & 511, lane); }
            for (int rr0 = gw * 4; rr0 < R; rr0 += NGW * 4) {
                const int row0 = PH_REV ? R - 4 - rr0 : rr0;
                const int mb = row_mb(row0); const float* xr = row0 < MP ? x_prompt + (size_t)row0 * 1024 : x_sample + (size_t)(row0 - MP) * 1024;
                const float* ngp = norm_g; const float* scp = mod + (size_t)mb * 3072 + 1024;
                f32x4 v[4][4], a4[4];
#pragma unroll
                for (int r = 0; r < 4; ++r)
#pragma unroll
                    for (int j = 0; j < 4; ++j) v[r][j] = *(const f32x4*)(xr + (size_t)r * 1024 + 4 * lane + 256 * j);
#pragma unroll
                for (int j = 0; j < 4; ++j) { const int c = 4 * lane + 256 * j; a4[j] = *(const f32x4*)(ngp + c) * (*(const f32x4*)(scp + c) + 1.f); }
#pragma unroll
                for (int r = 0; r < 4; ++r) { float sq = 0.f;
#pragma unroll
                    for (int j = 0; j < 4; ++j) { const f32x4 x4 = v[r][j]; sq += (x4.x * x4.x + x4.y * x4.y) + (x4.z * x4.z + x4.w * x4.w);
                        const f32x4 a = x4 * a4[j]; u32x2 o; o.x = cvtpk(a.x, a.y); o.y = cvtpk(a.z, a.w); *(u32x2*)(XA + (size_t)(row0 + r) * 1024 + 4 * lane + 256 * j) = o; }
                    sq = wave_sum(sq); if (lane == 0) *(f32x4*)(ssq + (size_t)(row0 + r) * 4) = (f32x4){sq, 0.f, 0.f, 0.f}; }
            }
        } else if (ph == N_PHASES - 1) {
            for (int rr0 = gw * 4; rr0 < R; rr0 += NGW * 4) {
                const int row0 = PH_REV ? R - 4 - rr0 : rr0;
                f32x4 v[4][4], gf[4]; float rs[4];
#pragma unroll
                for (int r = 0; r < 4; ++r) { const f32x4 sp = *(const f32x4*)(ssq + ((size_t)4 * R + row0 + r) * 4); rs[r] = (sp.x + sp.y) + (sp.z + sp.w);
#pragma unroll
                    for (int j = 0; j < 4; ++j) { const u32x2 xb = *(const u32x2*)((const bf16_t*)(ws + WS_XB) + (size_t)(row0 + r) * 1024 + 4 * lane + 256 * j); v[r][j] = (f32x4){bf_lo(xb.x), bf_hi(xb.x), bf_lo(xb.y), bf_hi(xb.y)}; } }
#pragma unroll
                for (int j = 0; j < 4; ++j) gf[j] = *(const f32x4*)(final_g + 4 * lane + 256 * j);
#pragma unroll
                for (int r = 0; r < 4; ++r) { const float rr = rsqrtf(rs[r] * (1.f / 1024.f) + EPS);
#pragma unroll
                    for (int j = 0; j < 4; ++j) *(f32x4*)(out + (size_t)(row0 + r) * 1024 + 4 * lane + 256 * j) = v[r][j] * rr * gf[j]; }
            }
        } else {
            const int li = (ph - 2) / 3, k = (ph - 2) % 3, j = li >> 1, attn = li & 1;
            if (k == 0) {
                pg8::Gemm g{XA, attn ? attnBt + (size_t)j * 2560 * 1024 : poolBt + (size_t)j * 3072 * 1024, R, attn ? 2560 : 2048, 1024};
                pg8::TileOrder S; S.init(R / 256, attn ? 10 : 8, G, bid, attn ? 0 : 136, PH_REV, WGM_IN);
                EpiIn E{li | (EPI_PROBE ? rep * EPI_PROBE * 256 : 0), ka, lds};
                pg8::gemm_phase<EpiIn, pg8::TileOrder, true, true>(lds, g, S, E);
            } else if (k == 1) {
                if (!attn) pool_phase(B1, B2, B3, pool_scale + j * 1024, hv + (size_t)j * 16 * 15 * 1024, G, bid, PH_REV);
                else attn_phase(lds, B1, KBuf, VBuf, B2, B3, cache_k + (size_t)j * 16 * 128 * 256, cache_v + (size_t)j * 16 * 128 * 256, attn_sinks + j * 16, G, bid, PH_REV);
            } else {
                pg8::Gemm g{B3, attn ? attnOutBt + (size_t)j * 1048576 : poolOutBt + (size_t)j * 1048576, R, 1024, 1024};
                if (SMALL_OUT) { for (int ti = bid; ti < 256; ti += G) small_out_tile(lds, ti, li, ka); }
                pg8::TileOrder S; S.init(SMALL_OUT ? 256 : R / 256, 4, G, bid, 0, PH_REV, WGM_OUT);
                EpiOut E{li | (rep << 8), ka, lds};
                pg8::gemm_phase<EpiOut, pg8::TileOrder, true, true>(lds, g, S, E);
            }
        }
#ifndef SYNC_REP
#define SYNC_REP 1
#endif
#ifndef USE_XBAR
#define USE_XBAR 1
#endif
        if (ph + 1 < ph_hi || rep + 1 < nrep) {
            for (int sr = 0; sr < SYNC_REP; ++sr) {
                if (USE_XBAR && xbar.bar) xcd_barrier(xbar);
                else { grid.sync(); if (USE_XBAR && ph == 0) xbar = xcd_barrier_post((unsigned*)(ws + WS_BAR), (volatile LAS unsigned*)(lds + LDS_MISC)); }
            }
        }
        }
    }
}

#undef out
#undef ws
#undef ssq
#undef mod
#undef biasv
#undef Wp
#undef hv
#undef XA
#undef B1
#undef B2
#undef B3
#ifndef MK_SPLIT
#define MK_SPLIT 0
#endif
extern "C" void kernel_launch(void* const* d_in, const int* in_sizes, int n_in, void* d_out, int out_size, void* d_ws, size_t ws_size, hipStream_t stream) {
    static int grid = 0;
    if (grid == 0) {
        if (n_in != 18 || out_size != (int)OUT_TOTAL || ws_size < WS_END) { fprintf(stderr, "kernel_launch: unexpected shapes (n_in %d, out %d, ws %zu)\n", n_in, out_size, ws_size); grid = -1; return; }
        int dev = 0, cus = 0, per_cu = 0;
        (void)hipGetDevice(&dev); (void)hipDeviceGetAttribute(&cus, hipDeviceAttributeMultiprocessorCount, dev);
        if (hipFuncSetAttribute((const void*)mk_fwd, hipFuncAttributeMaxDynamicSharedMemorySize, LDS_BYTES) != hipSuccess) { fprintf(stderr, "kernel_launch: hipFuncSetAttribute failed\n"); grid = -1; return; }
        if (hipOccupancyMaxActiveBlocksPerMultiprocessor(&per_cu, (const void*)mk_fwd, NTHR, LDS_BYTES) != hipSuccess || per_cu < 1) { fprintf(stderr, "kernel_launch: occupancy query failed (%d)\n", per_cu); per_cu = 1; }
        (void)hipGetLastError();
        grid = cus * per_cu;
        if (grid <= 0) { grid = -1; return; }
    }
    if (grid < 0) return;
    Args a{};
    for (int i = 0; i < 18; ++i) a.in[i] = (const float*)d_in[i];
    a.out = (float*)d_out; a.ws = (unsigned char*)d_ws;
#if MK_SPLIT
    for (int ph = 0; ph < N_PHASES; ++ph) { a.ph_lo = ph; a.ph_hi = ph + 1; hipLaunchKernelGGL(mk_fwd, dim3(grid), dim3(NTHR), LDS_BYTES, stream, a); }
#else
    a.ph_lo = 0; a.ph_hi = N_PHASES;
    if (HOST_ZERO_BAR && hipMemsetAsync((unsigned char*)d_ws + WS_BAR, 0, XCD_BAR_WORDS * 4, stream) != hipSuccess) { fprintf(stderr, "kernel_launch: hipMemsetAsync of the barrier words failed\n"); return; }
    void* kargs[] = {&a};
    hipError_t e = hipLaunchCooperativeKernel((const void*)mk_fwd, dim3(grid), dim3(NTHR), kargs, LDS_BYTES, stream);
    if (e != hipSuccess) fprintf(stderr, "kernel_launch: cooperative launch failed: %s (grid %d)\n", hipGetErrorString(e), grid);
#endif
}
```

```cpp
#include <hip/hip_runtime.h>
#include <hip/hip_cooperative_groups.h>
#include <cstdio>
#include <cstdint>
namespace cg = cooperative_groups;
namespace pg8 {
#define PG8_LAS __attribute__((address_space(3)))
typedef unsigned short bf16_t;
typedef short bf16x8 __attribute__((ext_vector_type(8)));
typedef float f32x4 __attribute__((ext_vector_type(4)));
typedef unsigned u32x4 __attribute__((ext_vector_type(4)));
constexpr int BM = 256, BK = 64, HALF = 128, HTB = HALF * BK * 2  , STAGE_BYTES = 8 * HTB, NXCD = 8, WGM = 8;

__host__ __device__ __forceinline__ int lds_byte(int r, int c) { const int st = (r >> 4) * 2 + (c >> 5), rr = r & 15, cc = c & 31, ob = rr * 64 + cc * 2; return st * 1024 + (ob ^ (((ob >> 9) & 1) << 5)); }
__host__ __device__ __forceinline__ void stage_rc(int b, int& R, int& C) { const int st = b / 1024, sb = b % 1024, swz = sb ^ (((sb >> 9) & 1) << 5); R = (st >> 1) * 16 + swz / 64; C = (st & 1) * 32 + (swz % 64) / 2; }
__host__ __device__ __forceinline__ int perm32(int rho) { const int n = rho >> 4, i = rho & 15; return 8 * (i >> 2) + 4 * n + (i & 3); }

struct Unit { int pm, pn; };
struct Gemm { const bf16_t* A; const bf16_t* Bt; int M, N, K; };

template <class Epi, class Sched, bool ALIGN_EPI = false, bool SP2 = false>
__device__ __forceinline__ void gemm_phase(PG8_LAS unsigned char* lds, const Gemm g, const Sched& S, const Epi& E) {
    int tid; asm volatile("v_mov_b32 %0, %1" : "=v"(tid) : "v"((int)threadIdx.x));
    const int wid = __builtin_amdgcn_readfirstlane(tid >> 6), lane = tid & 63, wr = wid >> 2, wc = wid & 3, fr = lane & 15, fq = lane >> 4;
    const int K = g.K, nt = K / BK;
    unsigned voffA[2], voffB[2];
#pragma unroll
    for (int i = 0; i < 2; ++i) { int R, C; stage_rc(tid * 16 + i * 8192, R, C); const int Rb = Epi::PERM64 ? ((R >> 5) * 64 + perm32(R & 31)) : (Epi::PERM ? ((R & ~31) + perm32(R & 31)) : R);
        voffA[i] = (unsigned)(R * K + C) * 2u; voffB[i] = (unsigned)(Rb * K + C) * 2u; }
    const size_t kstep = (size_t)(BK * 2);
    const size_t hstep = (size_t)HALF * K * 2;
    const size_t hstepB = Epi::PERM64 ? (size_t)32 * K * 2 : hstep;
    const size_t tstep = 2 * hstep;
    const unsigned ldsw = (unsigned)wid * 1024u;
    const int aoff = lds_byte(wr * 64 + fr, fq * 8), boff = lds_byte(wc * 32 + fr, fq * 8);
#define PG8_SA(b, h) (((b) * 2 + (h)) * HTB)
#define PG8_SB(b, h) ((4 + (b) * 2 + (h)) * HTB)
#define PG8_STAGE(bufoff, gbase, voff) do { _Pragma("unroll") for (int _i = 0; _i < 2; ++_i) \
        __builtin_amdgcn_global_load_lds((const unsigned*)((const char*)(gbase) + (voff)[_i]), (PG8_LAS unsigned*)(lds + (bufoff) + ldsw + _i * 8192), 16, 0, 0); } while (0)
#define PG8_LDA(dst, b, h) do { _Pragma("unroll") for (int m = 0; m < 4; ++m) _Pragma("unroll") for (int k = 0; k < 2; ++k) dst[m][k] = *(const PG8_LAS bf16x8*)(lds + PG8_SA(b, h) + aoff + m * 2048 + k * 1024); } while (0)
#define PG8_LDB(dst, b, h) do { _Pragma("unroll") for (int n = 0; n < 2; ++n) _Pragma("unroll") for (int k = 0; k < 2; ++k) dst[n][k] = *(const PG8_LAS bf16x8*)(lds + PG8_SB(b, h) + boff + n * 2048 + k * 1024); } while (0)
#define PG8_MMA(ai, bj, At, Bt) do { __builtin_amdgcn_s_setprio(1); _Pragma("unroll") for (int m = 0; m < 4; ++m) _Pragma("unroll") for (int n = 0; n < 2; ++n) _Pragma("unroll") for (int k = 0; k < 2; ++k) \
        acc[ai][bj][m][n] = __builtin_amdgcn_mfma_f32_16x16x32_bf16(Bt[n][k], At[m][k], acc[ai][bj][m][n], 0, 0, 0); __builtin_amdgcn_s_setprio(0); } while (0)
#define PG8_WAIT_V(n) asm volatile("s_waitcnt vmcnt(" #n ")" ::: "memory")
#define PG8_WAIT_L(n) asm volatile("s_waitcnt lgkmcnt(" #n ")" ::: "memory")
#define PG8_BAR __builtin_amdgcn_s_barrier()
#define PG8_SCHED __builtin_amdgcn_sched_barrier(0)
    Unit cur, nxt; int ui = 0;
    if (!S.next(0, cur)) return;
    f32x4 acc[2][2][4][2];
#pragma unroll
    for (int a = 0; a < 2; ++a)
#pragma unroll
        for (int b = 0; b < 2; ++b)
#pragma unroll
            for (int m = 0; m < 4; ++m)
#pragma unroll
                for (int n = 0; n < 2; ++n) acc[a][b][m][n] = (f32x4){0.f, 0.f, 0.f, 0.f};
    bf16x8 At[4][2], B0[2][2], B1[2][2];
    const char* cA = (const char*)g.A + (size_t)cur.pm * tstep; const char* cB = (const char*)g.Bt + (size_t)cur.pn * tstep;
    S.a_ready(cur);
    if constexpr (SP2) {
        PG8_STAGE(PG8_SB(0, 0), cB, voffB); PG8_STAGE(PG8_SB(0, 1), cB + hstepB, voffB); PG8_STAGE(PG8_SA(0, 0), cA, voffA); PG8_STAGE(PG8_SA(0, 1), cA + hstep, voffA);
        if (wr == 1) PG8_BAR;
        PG8_WAIT_V(2); PG8_BAR;
        PG8_STAGE(PG8_SB(1, 0), cB + kstep, voffB); PG8_STAGE(PG8_SA(1, 0), cA + kstep, voffA); PG8_STAGE(PG8_SB(1, 1), cB + hstepB + kstep, voffB);
        PG8_WAIT_V(6); PG8_BAR;
    } else {
        PG8_STAGE(PG8_SB(0, 0), cB, voffB); PG8_STAGE(PG8_SA(0, 0), cA, voffA); PG8_STAGE(PG8_SB(0, 1), cB + hstepB, voffB); PG8_STAGE(PG8_SA(0, 1), cA + hstep, voffA);
        if (wr == 1) PG8_BAR;
        PG8_WAIT_V(4); PG8_BAR;
        PG8_STAGE(PG8_SB(1, 0), cB + kstep, voffB); PG8_STAGE(PG8_SA(1, 0), cA + kstep, voffA); PG8_STAGE(PG8_SB(1, 1), cB + hstepB + kstep, voffB);
        PG8_WAIT_V(6); PG8_BAR;
    }
    for (;;) {
        const bool has_next = S.next(ui + 1, nxt);
        if constexpr (Epi::STAGE) E.stage(cur, lds, tid, wid, ui & 1);
        const char* nA = has_next ? (const char*)g.A + (size_t)nxt.pm * tstep : cA; const char* nB = has_next ? (const char*)g.Bt + (size_t)nxt.pn * tstep : cB;
        for (int t = 0; t < nt; t += 2) {
            const bool last = (t == nt - 2);
            const char* a1 = cA + (size_t)(t + 1) * kstep;
            const char* a2 = last ? nA : cA + (size_t)(t + 2) * kstep; const char* b2 = last ? nB : cB + (size_t)(t + 2) * kstep;
            const char* a3 = a2 + kstep; const char* b3 = b2 + kstep;
            if (last && has_next) S.a_ready(nxt);
            if constexpr (SP2) {
            PG8_LDB(B0, 0, 0); PG8_LDB(B1, 0, 1); PG8_SCHED; PG8_LDA(At, 0, 0); PG8_STAGE(PG8_SA(1, 1), a1 + hstep, voffA);
            PG8_WAIT_V(8); PG8_WAIT_L(0); PG8_BAR; PG8_MMA(0, 0, At, B0); PG8_MMA(0, 1, At, B1); PG8_BAR; PG8_SCHED;
            PG8_LDA(At, 0, 1); PG8_STAGE(PG8_SB(0, 0), b2, voffB); PG8_STAGE(PG8_SB(0, 1), b2 + hstepB, voffB); PG8_STAGE(PG8_SA(0, 0), a2, voffA);
            PG8_WAIT_V(8); PG8_WAIT_L(0); PG8_BAR; PG8_MMA(1, 0, At, B0); PG8_MMA(1, 1, At, B1); PG8_BAR; PG8_SCHED;
            PG8_LDB(B0, 1, 0); PG8_LDB(B1, 1, 1); PG8_SCHED; PG8_LDA(At, 1, 0); PG8_STAGE(PG8_SA(0, 1), a2 + hstep, voffA);
            PG8_WAIT_V(8); PG8_WAIT_L(0); PG8_BAR; PG8_MMA(0, 0, At, B0); PG8_MMA(0, 1, At, B1); PG8_BAR; PG8_SCHED;
            PG8_LDA(At, 1, 1); PG8_STAGE(PG8_SB(1, 0), b3, voffB); PG8_STAGE(PG8_SB(1, 1), b3 + hstepB, voffB); PG8_STAGE(PG8_SA(1, 0), a3, voffA);
            PG8_WAIT_V(8); PG8_WAIT_L(0); PG8_BAR; PG8_MMA(1, 0, At, B0); PG8_MMA(1, 1, At, B1); PG8_BAR; PG8_SCHED;
            } else {
            PG8_LDB(B0, 0, 0); PG8_SCHED; PG8_LDA(At, 0, 0); PG8_STAGE(PG8_SA(1, 1), a1 + hstep, voffA);
            PG8_WAIT_L(8); PG8_BAR; PG8_WAIT_L(0); PG8_MMA(0, 0, At, B0); PG8_BAR; PG8_SCHED;
            PG8_LDB(B1, 0, 1); PG8_STAGE(PG8_SB(0, 0), b2, voffB);
            PG8_BAR; PG8_WAIT_L(0); PG8_MMA(0, 1, At, B1); PG8_BAR;
            PG8_LDA(At, 0, 1); PG8_STAGE(PG8_SA(0, 0), a2, voffA);
            PG8_BAR; PG8_WAIT_L(0); PG8_MMA(1, 0, At, B0); PG8_BAR; PG8_SCHED;
            PG8_STAGE(PG8_SB(0, 1), b2 + hstepB, voffB);
            PG8_WAIT_V(6); PG8_BAR; PG8_MMA(1, 1, At, B1); PG8_BAR;
            PG8_LDB(B0, 1, 0); PG8_SCHED; PG8_LDA(At, 1, 0); PG8_STAGE(PG8_SA(0, 1), a2 + hstep, voffA);
            PG8_WAIT_L(8); PG8_BAR; PG8_WAIT_L(0); PG8_MMA(0, 0, At, B0); PG8_BAR; PG8_SCHED;
            PG8_LDB(B1, 1, 1); PG8_STAGE(PG8_SB(1, 0), b3, voffB);
            PG8_BAR; PG8_WAIT_L(0); PG8_MMA(0, 1, At, B1); PG8_BAR;
            PG8_LDA(At, 1, 1); PG8_STAGE(PG8_SA(1, 0), a3, voffA);
            PG8_BAR; PG8_WAIT_L(0); PG8_MMA(1, 0, At, B0); PG8_BAR; PG8_SCHED;
            PG8_STAGE(PG8_SB(1, 1), b3 + hstepB, voffB);
            PG8_WAIT_V(6); PG8_BAR; PG8_MMA(1, 1, At, B1); PG8_BAR;
            }
        }
        if constexpr (ALIGN_EPI) { if (wr == 0) PG8_BAR; }
#ifndef PF_NEXT_A
#define PF_NEXT_A 0
#endif
        if (PF_NEXT_A && Epi::PF && has_next) {
            const char* pp = nA + (size_t)(tid >> 4) * (size_t)(K * 2) + (size_t)(tid & 15) * 128;
#pragma unroll 1
            for (int i = 0; i < 8; ++i) { __builtin_amdgcn_global_load_lds((const unsigned*)pp, (PG8_LAS unsigned*)(lds + 135168 + wid * 256), 4, 0, 0); pp += (size_t)32 * (size_t)(K * 2); }
        }
        if constexpr (!Epi::AFTER_DRAIN) { E(acc, cur, wr, wc, fr, fq, ui & 1); S.done(cur); }
        if (!has_next) break;
#pragma unroll
        for (int a = 0; a < 2; ++a)
#pragma unroll
            for (int b = 0; b < 2; ++b)
#pragma unroll
                for (int m = 0; m < 4; ++m)
#pragma unroll
                    for (int n = 0; n < 2; ++n) acc[a][b][m][n] = (f32x4){0.f, 0.f, 0.f, 0.f};
        cur = nxt; cA = nA; cB = nB; ++ui;
        if constexpr (ALIGN_EPI) { if (wr == 1) PG8_BAR; }
    }
    PG8_WAIT_V(0);
    if constexpr (!ALIGN_EPI) { if (wr == 0) PG8_BAR; }
    PG8_BAR;
    if constexpr (Epi::AFTER_DRAIN) { E.fused(acc, cur, wr, wc, fr, fq, lds, wid, lane); S.done(cur); }
#undef PG8_SA
#undef PG8_SB
#undef PG8_STAGE
#undef PG8_LDA
#undef PG8_LDB
#undef PG8_MMA
#undef PG8_WAIT_V
#undef PG8_WAIT_L
#undef PG8_BAR
#undef PG8_SCHED
}
}
namespace pg8 {
struct TileOrder {
    int nM, nN, nwg, G, c, nextra, rev, wgm;
    __device__ __forceinline__ void init(int nM_, int nN_, int G_, int c_, int nextra_, int rev_, int wgm_) { nM = nM_; nN = nN_; nwg = nM * nN; G = G_; c = c_; nextra = nextra_; rev = rev_; wgm = wgm_; }
    __device__ __forceinline__ bool next(int i, Unit& u) const {
        long L = (long)i * G + c; if (L >= nwg + nextra) return false;
        if (rev) L = (long)(nwg + nextra) - 1 - L;
        if (L >= nwg) { const int e = (int)L - nwg, ti = e >> 2; u.pn = 8 + (e & 3); u.pm = ti < 32 ? 8 * ti + 7 : 256 + (ti - 32); return true; }
        int wgid = (int)L; { const int q = nwg / NXCD, r = nwg % NXCD, xcd = wgid % NXCD, off = wgid / NXCD; wgid = (xcd < r ? xcd * (q + 1) : r * (q + 1) + (xcd - r) * q) + off; }
        const int nig = wgm * nN, gid = wgid / nig, fm = gid * wgm, gsz = (nM - fm) < wgm ? (nM - fm) : wgm;
        u.pm = fm + ((wgid % nig) % gsz); u.pn = (wgid % nig) / gsz; return true;
    }
    __device__ __forceinline__ void a_ready(const Unit&) const {}
    __device__ __forceinline__ void done(const Unit&) const {}
};
}
#define GAS __attribute__((address_space(1)))
#define LAS __attribute__((address_space(3)))
#define DI __device__ __forceinline__
using pg8::bf16_t; using pg8::bf16x8; using pg8::f32x4; using pg8::u32x4; using pg8::Unit;
typedef float f32x16 __attribute__((ext_vector_type(16)));
typedef float f32x2_t __attribute__((ext_vector_type(2)));
typedef __bf16 bf16x2_t __attribute__((ext_vector_type(2)));
typedef short s16x4 __attribute__((ext_vector_type(4)));
typedef unsigned u32x2 __attribute__((ext_vector_type(2)));

constexpr int D = 1024, SEQ = 2048, MP = 32 * 2048, MS = 16 * 32, R = MP + MS, NB = 48;
constexpr int NWAVES = 8, NTHR = 512;
constexpr float EPS = 1e-6f, LOG2E = 1.4426950408889634f, QSCALE = 0.125f * LOG2E;
constexpr int LDS_BYTES = 153600;
constexpr int LDS_RED = 131072;
constexpr int LDS_STG = 137216;
constexpr int LDS_MISC = 152576;
constexpr size_t OFF_YS = 67108864, OFF_PP = 67633152, OFF_KP = 68616192, OFF_VP = 70713344, OFF_PS = 72810496, OFF_KS = 73302016, OFF_VS = 74350592, OUT_TOTAL = 75399168;
constexpr size_t MiB = 1u << 20;
constexpr size_t WS_BAR = 0  , WS_HVB = 65536  , WS_MOD = 2 * MiB, WS_BIAS = 5 * MiB, WS_WP = 8 * MiB, WS_HV = 16 * MiB, WS_POOLBT = 18 * MiB, WS_ATTNBT = 30 * MiB, WS_POOLOUT = 40 * MiB, WS_ATTNOUT = 44 * MiB;
constexpr size_t WS_XA = 48 * MiB, WS_B1 = 177 * MiB, WS_B2 = 306 * MiB, WS_B3 = 435 * MiB, WS_KB = 564 * MiB, WS_VB = 597 * MiB, WS_SSQ = 630 * MiB  , WS_XB = 636 * MiB  , WS_END = 765 * MiB;
static_assert((size_t)R * D * 2 <= 129 * MiB && (size_t)R * 256 * 2 <= 33 * MiB, "ws map");

DI int opaque_tid() { int t; asm volatile("v_mov_b32 %0, %1" : "=v"(t) : "v"((int)threadIdx.x)); return t; }
DI unsigned cvtpk(float lo, float hi) { f32x2_t v = {lo, hi}; bf16x2_t b = __builtin_convertvector(v, bf16x2_t); return __builtin_bit_cast(unsigned, b); }
DI float bf_lo(unsigned u) { return __uint_as_float(u << 16); }
DI float bf_hi(unsigned u) { return __uint_as_float(u & 0xffff0000u); }
DI float silu_f(float x) { return x * __builtin_amdgcn_rcpf(1.f + __expf(-x)); }
DI int row_mb(int row) { return row < MP ? (row >> 11) : 32 + ((row - MP) >> 5); }
DI u32x4 pack8(f32x4 a, f32x4 b) { u32x4 w; w.x = cvtpk(a.x, a.y); w.y = cvtpk(a.z, a.w); w.z = cvtpk(b.x, b.y); w.w = cvtpk(b.z, b.w); return w; }
DI void unpack8(u32x4 w, float (&f)[8]) { f[0] = bf_lo(w.x); f[1] = bf_hi(w.x); f[2] = bf_lo(w.y); f[3] = bf_hi(w.y); f[4] = bf_lo(w.z); f[5] = bf_hi(w.z); f[6] = bf_lo(w.w); f[7] = bf_hi(w.w); }

struct Args { const float* in[18]; float* out; unsigned char* ws; int ph_lo, ph_hi; };
typedef const volatile __attribute__((address_space(4))) Args* KArgs;

#ifndef WGM_IN
#define WGM_IN 8
#endif
#ifndef WGM_OUT
#define WGM_OUT 8
#endif
#ifndef SMALL_OUT
#define SMALL_OUT 1
#endif
#ifndef EPI_PROBE
#define EPI_PROBE 0
#endif
#ifndef PF_IN
#define PF_IN true
#endif
#ifndef PF_OUT
#define PF_OUT true
#endif
DI u32x4 dpp_ror8(u32x4 v) { u32x4 r; r.x = (unsigned)__builtin_amdgcn_mov_dpp((int)v.x, 0x128, 0xf, 0xf, true); r.y = (unsigned)__builtin_amdgcn_mov_dpp((int)v.y, 0x128, 0xf, 0xf, true);
    r.z = (unsigned)__builtin_amdgcn_mov_dpp((int)v.z, 0x128, 0xf, 0xf, true); r.w = (unsigned)__builtin_amdgcn_mov_dpp((int)v.w, 0x128, 0xf, 0xf, true); return r; }
DI void store_pair(bf16_t* base, int ld, int rowbase, int fr, int c0, u32x4 p0, u32x4 p1) {
    const bool lo = fr < 8;
    const u32x4 recv = dpp_ror8(lo ? p1 : p0);
    bf16_t* a = base + (size_t)(rowbase + (fr & 7)) * ld + c0 + (fr >> 3) * 32;
    *(u32x4*)a = lo ? p0 : recv; *(u32x4*)(a + (size_t)8 * ld) = lo ? recv : p1;
}
DI void load_pair(const bf16_t* base, int ld, int rowbase, int fr, int c0, u32x4& p0, u32x4& p1) {
    const bool lo = fr < 8;
    const bf16_t* a = base + (size_t)(rowbase + (fr & 7)) * ld + c0 + (fr >> 3) * 32;
    const u32x4 A = *(const u32x4*)a, B = *(const u32x4*)(a + (size_t)8 * ld);
    const u32x4 recv = dpp_ror8(lo ? B : A);
    p0 = lo ? A : recv; p1 = lo ? recv : B;
}
struct EpiIn {
    static constexpr bool PERM = true, PERM64 = true, AFTER_DRAIN = false, PF = PF_IN, STAGE = true; static constexpr int NPF = 8;
    int li_;
    KArgs ka; LAS unsigned char* lds_;
    DI void stage(const Unit& u, LAS unsigned char* lds, int tid, int wid, int par) const {
        unsigned char* ws = ka->ws; const int li = li_ & 255;
        LAS unsigned char* st = lds + LDS_STG + par * 5120;
        if (wid < 4) __builtin_amdgcn_global_load_lds((const unsigned*)((const float*)(ws + WS_SSQ) + ((size_t)li * R + (size_t)u.pm * 256 + tid) * 4), (LAS unsigned*)(st + wid * 1024), 16, 0, 0);
        if (wid == 4 && u.pm < 256) __builtin_amdgcn_global_load_lds((const unsigned*)((const float*)(ws + WS_BIAS) + (size_t)li * NB * 3072 + (u.pm >> 3) * 3072 + u.pn * 256 + (tid & 63) * 4), (LAS unsigned*)(st + 4096), 16, 0, 0);
    }
    DI void operator()(const f32x4 (&acc)[2][2][4][2], const Unit& u, int wr, int wc, int fr, int fq, int par) const {
        const int li = li_ & 255;
        const LAS unsigned char* st = lds_ + LDS_STG + par * 5120;
        if (EPI_PROBE && (li_ & 256)) { if (acc[0][0][0][0].x == 1.2345e30f) asm volatile("s_nop 0"); return; }
        const int pn = u.pn, attn = li & 1, j = li >> 1;
        unsigned char* ws = ka->ws; float* out = ka->out;
        const float* ssq = (const float*)(ws + WS_SSQ) + (size_t)li * R * 4; const float* biasv = (const float*)(ws + WS_BIAS) + (size_t)li * NB * 3072;
        bf16_t* B1 = (bf16_t*)(ws + WS_B1); bf16_t* B2 = (bf16_t*)(ws + WS_B2); bf16_t* KB = (bf16_t*)(ws + WS_KB); bf16_t* VB = (bf16_t*)(ws + WS_VB);
        float* o_pp = out + OFF_PP + (size_t)j * 32 * 15 * 1024; float* o_ps = out + OFF_PS + (size_t)j * 16 * 15 * 1024;
        float* o_kp = out + OFF_KP + (size_t)j * 32 * 128 * 256; float* o_vp = out + OFF_VP + (size_t)j * 32 * 128 * 256; float* o_ks = out + OFF_KS + (size_t)j * 16 * 128 * 256; float* o_vs = out + OFF_VS + (size_t)j * 16 * 128 * 256;
        int kind, cbase; float qs = 1.f;
        if (!attn) { kind = pn < 4 ? 0 : (pn < 8 ? 1 : 4); cbase = pn < 4 ? 0 : (pn < 8 ? 1024 : 2048); }
        else if (pn < 4) { kind = 0; cbase = 0; qs = QSCALE; }
        else if (pn == 4) { kind = 2; cbase = 1024; }
        else if (pn == 5) { kind = 3; cbase = 1280; }
        else { kind = 1; cbase = 1536; }
        const int colg = pn * 256 + wc * 64 + 8 * fq;
        if (u.pm < 256) rows<true>(acc, u, wr, wc, fq, st, fr, kind, attn != 0, cbase, qs, colg, ssq, biasv, B1, B2, KB, VB, o_pp, o_ps, o_kp, o_vp, o_ks, o_vs);
        else rows<false>(acc, u, wr, wc, fq, st, fr, kind, attn != 0, cbase, qs, colg, ssq, biasv, B1, B2, KB, VB, o_pp, o_ps, o_kp, o_vp, o_ks, o_vs);
    }
    template <bool UNI> DI void rows(const f32x4 (&acc)[2][2][4][2], const Unit& u, int wr, int wc, int fq, const LAS unsigned char* st, int fr, int kind, bool silu_here, int cbase, float qs, int colg, const float* ssq, const float* biasv,
                                     bf16_t* B1, bf16_t* B2, bf16_t* KB, bf16_t* VB, float* o_pp, float* o_ps, float* o_kp, float* o_vp, float* o_ks, float* o_vs) const {
        f32x4 bu[2][2];
        if (UNI) {
#pragma unroll
            for (int bj = 0; bj < 2; ++bj)
#pragma unroll
                for (int n = 0; n < 2; ++n) bu[bj][n] = *(const LAS f32x4*)(st + 4096 + (wc * 64 + 8 * fq + bj * 32 + 4 * n) * 4);
        }
#pragma unroll
        for (int ai = 0; ai < 2; ++ai)
#pragma unroll
            for (int m = 0; m < 4; ++m) {
                const int rowbase = u.pm * 256 + ai * 128 + wr * 64 + m * 16, row = rowbase + fr;
                const f32x4 sp = *(const LAS f32x4*)(st + (ai * 128 + wr * 64 + m * 16 + fr) * 16);
                const float rs = rsqrtf(((sp.x + sp.y) + (sp.z + sp.w)) * (1.f / 1024.f) + EPS);
                const float* bp = biasv + (UNI ? 0 : row_mb(row)) * 3072 + colg;
                u32x4 P[2];
#pragma unroll
                for (int bj = 0; bj < 2; ++bj) {
                    const f32x4 b0 = UNI ? bu[bj][0] : *(const f32x4*)(bp + bj * 32), b1 = UNI ? bu[bj][1] : *(const f32x4*)(bp + bj * 32 + 4);
                    f32x4 v0 = acc[ai][bj][m][0] * rs + b0, v1 = acc[ai][bj][m][1] * rs + b1;
                    const int c = colg + bj * 32 - cbase;
                    if (kind == 0) { v0 = v0 * qs; v1 = v1 * qs; }
                    else if (kind == 1) {
                        if (silu_here) {
                            v0.x = silu_f(v0.x); v0.y = silu_f(v0.y); v0.z = silu_f(v0.z); v0.w = silu_f(v0.w);
                            v1.x = silu_f(v1.x); v1.y = silu_f(v1.y); v1.z = silu_f(v1.z); v1.w = silu_f(v1.w);
                        }
                    } else if (kind == 4) {
                        float* dst = nullptr;
                        if (row < MP) { const int t = row & 2047; if (t >= SEQ - 15) dst = o_pp + ((size_t)(row >> 11) * 15 + (t - (SEQ - 15))) * 1024 + c; }
                        else { const int t = (row - MP) & 31; if (t >= 17) dst = o_ps + ((size_t)((row - MP) >> 5) * 15 + (t - 17)) * 1024 + c; }
                        if (dst) { *(f32x4*)dst = v0; *(f32x4*)(dst + 4) = v1; }
                    } else {
                        float* dst = nullptr;
                        if (row < MP) { const int t = row & 2047; if (t >= SEQ - 128) dst = (kind == 2 ? o_kp : o_vp) + ((size_t)(row >> 11) * 128 + (t - (SEQ - 128))) * 256 + c; }
                        else { const int t = (row - MP) & 31; dst = (kind == 2 ? o_ks : o_vs) + ((size_t)((row - MP) >> 5) * 128 + 96 + t) * 256 + c; }
                        if (dst) { *(f32x4*)dst = v0; *(f32x4*)(dst + 4) = v1; }
                    }
                    P[bj] = pack8(v0, v1);
                }
                if (kind == 0) store_pair(B1, 1024, rowbase, fr, colg - cbase, P[0], P[1]);
                else if (kind == 1) store_pair(B2, 1024, rowbase, fr, colg - cbase, P[0], P[1]);
                else if (kind == 2) store_pair(KB, 256, rowbase, fr, colg - cbase, P[0], P[1]);
                else if (kind == 3) store_pair(VB, 256, rowbase, fr, colg - cbase, P[0], P[1]);
            }
    }
};

struct EpiOut {
    static constexpr bool PERM = true, PERM64 = true, AFTER_DRAIN = false, PF = PF_OUT, STAGE = false; static constexpr int NPF = 4;
    int li_; KArgs ka; LAS unsigned char* lds;
    DI void operator()(const f32x4 (&acc)[2][2][4][2], const Unit& u, int wr, int wc, int fr, int fq, int) const {
        const int li = li_ & 255;
        if (li_ >> 8) { if (acc[0][0][0][0].x == 1.2345e30f) asm volatile("s_nop 0"); return; }
        const float* xp_in = ka->in[0]; const float* xs_in = ka->in[1]; const float* norm_g = ka->in[7]; float* xo = ka->out; unsigned char* ws = ka->ws;
        const float* xp = xp_in; const float* xs = xs_in; bf16_t* XB = (bf16_t*)(ws + WS_XB);
        const float* gmod = (const float*)(ws + WS_MOD) + (size_t)li * NB * 3072;
        const float* ng = li == 3 ? nullptr : norm_g + (li + 1) * 1024;
        const float* nmod = gmod + NB * 3072;
        bf16_t* XA = (bf16_t*)(ws + WS_XA); float* ssq = (float*)(ws + WS_SSQ) + (size_t)(li + 1) * R * 4;
        const int colg = u.pn * 256 + wc * 64 + 8 * fq;
        if (u.pm < 256) rows<true>(acc, u, wr, wc, fr, fq, colg, li == 0, xp, xs, XB, gmod, ng, nmod, XA);
        else rows<false>(acc, u, wr, wc, fr, fq, colg, li == 0, xp, xs, XB, gmod, ng, nmod, XA);
        asm volatile("s_waitcnt lgkmcnt(0)" ::: "memory"); __builtin_amdgcn_s_barrier();
        const int t = (wr * 4 + wc) * 64 + fq * 16 + fr;
        if (t < 256) { const f32x4 pr = *(const LAS f32x4*)(lds + LDS_RED + t * 16); ssq[((size_t)u.pm * 256 + t) * 4 + u.pn] = (pr.x + pr.y) + (pr.z + pr.w); }
    }
    template <bool UNI> DI void rows(const f32x4 (&acc)[2][2][4][2], const Unit& u, int wr, int wc, int fr, int fq, int colg, bool first, const float* xp, const float* xs, bf16_t* XB,
                                     const float* gmod, const float* ng, const float* nmod, bf16_t* XA) const {
        f32x4 gu[2][2], au[2][2];
        if (UNI) {
            const int mbu = u.pm >> 3;
#pragma unroll
            for (int bj = 0; bj < 2; ++bj)
#pragma unroll
                for (int n = 0; n < 2; ++n) { const int c = colg + bj * 32 + 4 * n; gu[bj][n] = *(const f32x4*)(gmod + mbu * 3072 + 2048 + c);
                    au[bj][n] = (f32x4){0.f, 0.f, 0.f, 0.f}; if (ng) au[bj][n] = *(const f32x4*)(ng + c) * (*(const f32x4*)(nmod + mbu * 3072 + 1024 + c) + 1.f); }
        }
#pragma unroll
        for (int ai = 0; ai < 2; ++ai)
#pragma unroll
            for (int m = 0; m < 4; ++m) {
                const int rowbase = u.pm * 256 + ai * 128 + wr * 64 + m * 16, row = rowbase + fr;
                const int mb = UNI ? 0 : row_mb(row);
                const float* xin = row < MP ? xp + (size_t)row * 1024 : xs + (size_t)(row - MP) * 1024;
                const float* gp = gmod + mb * 3072 + 2048;
                u32x4 xb[2];
                if (!first) load_pair(XB, 1024, rowbase, fr, colg, xb[0], xb[1]);
                u32x4 PX[2], PA[2];
                float ss = 0.f;
#pragma unroll
                for (int bj = 0; bj < 2; ++bj) {
                    const int c = colg + bj * 32;
                    f32x4 x0, x1;
                    if (first) { x0 = *(const f32x4*)(xin + c); x1 = *(const f32x4*)(xin + c + 4); }
                    else { x0 = (f32x4){bf_lo(xb[bj].x), bf_hi(xb[bj].x), bf_lo(xb[bj].y), bf_hi(xb[bj].y)}; x1 = (f32x4){bf_lo(xb[bj].z), bf_hi(xb[bj].z), bf_lo(xb[bj].w), bf_hi(xb[bj].w)}; }
                    const f32x4 g0 = UNI ? gu[bj][0] : *(const f32x4*)(gp + c), g1 = UNI ? gu[bj][1] : *(const f32x4*)(gp + c + 4);
                    x0 = x0 + g0 * acc[ai][bj][m][0]; x1 = x1 + g1 * acc[ai][bj][m][1];
                    PX[bj] = pack8(x0, x1);
                    ss += (x0.x * x0.x + x0.y * x0.y) + (x0.z * x0.z + x0.w * x0.w) + (x1.x * x1.x + x1.y * x1.y) + (x1.z * x1.z + x1.w * x1.w);
                    PA[bj] = (u32x4){0u, 0u, 0u, 0u};
                    if (ng) {
                        f32x4 a0, a1;
                        if (UNI) { a0 = au[bj][0]; a1 = au[bj][1]; }
                        else { a0 = *(const f32x4*)(ng + c) * (*(const f32x4*)(nmod + mb * 3072 + 1024 + c) + 1.f); a1 = *(const f32x4*)(ng + c + 4) * (*(const f32x4*)(nmod + mb * 3072 + 1024 + c + 4) + 1.f); }
                        PA[bj] = pack8(x0 * a0, x1 * a1);
                    }
                }
                store_pair(XB, 1024, rowbase, fr, colg, PX[0], PX[1]);
                if (ng) store_pair(XA, 1024, rowbase, fr, colg, PA[0], PA[1]);
                ss += __shfl_xor(ss, 16); ss += __shfl_xor(ss, 32);
                if (fq == 0) *(LAS float*)(lds + LDS_RED + ((ai * 128 + wr * 64 + m * 16 + fr) * 4 + wc) * 4) = ss;
            }
    }
};

#define MFMA32(a, b, c) __builtin_amdgcn_mfma_f32_32x32x16_bf16((a), (b), (c), 0, 0, 0)
DI void small_out_tile(LAS unsigned char* lds, int ti, int li, KArgs ka) {
    const int tid = opaque_tid(), lane = tid & 63, w = __builtin_amdgcn_readfirstlane(tid >> 6), hh = lane >> 5, l31 = lane & 31;
    unsigned char* ws = ka->ws;
    const int attn = li & 1, j = li >> 1;
    const bf16_t* A = (const bf16_t*)(ws + WS_B3);
    const bf16_t* Bt = (const bf16_t*)(ws + (attn ? WS_ATTNOUT : WS_POOLOUT)) + (size_t)j * 1048576;
    const int rt = ti >> 4, ct = ti & 15, row0 = MP + rt * 32, col0 = ct * 64, k0 = w * 128;
    const int row = tid >> 4, c4 = (tid & 15) * 4, grow = row0 + row, col = col0 + c4, mb = 32 + rt;
    const float* gmod = (const float*)(ws + WS_MOD) + (size_t)li * NB * 3072;
    bf16_t* XB = (bf16_t*)(ws + WS_XB);
    f32x4 xold = {0.f, 0.f, 0.f, 0.f}; u32x2 xbo = {0u, 0u};
    if (li == 0) xold = *(const f32x4*)(ka->in[1] + (size_t)(grow - MP) * 1024 + col); else xbo = *(const u32x2*)(XB + (size_t)grow * 1024 + col);
    const f32x4 gte = *(const f32x4*)(gmod + mb * 3072 + 2048 + col);
    f32x4 ngv = {0.f, 0.f, 0.f, 0.f}, scv = {0.f, 0.f, 0.f, 0.f};
    if (li < 3) { ngv = *(const f32x4*)(ka->in[7] + (li + 1) * 1024 + col); scv = *(const f32x4*)(gmod + NB * 3072 + mb * 3072 + 1024 + col); }
    bf16x8 af[8], bfr[2][8];
    { const bf16_t* ap = A + (size_t)(row0 + l31) * 1024 + k0 + hh * 8;
#pragma unroll
      for (int sx = 0; sx < 8; ++sx) af[sx] = *(const bf16x8*)(ap + 16 * sx);
#pragma unroll
      for (int nt = 0; nt < 2; ++nt) { const bf16_t* bp = Bt + (size_t)(col0 + nt * 32 + l31) * 1024 + k0 + hh * 8;
#pragma unroll
          for (int sx = 0; sx < 8; ++sx) bfr[nt][sx] = *(const bf16x8*)(bp + 16 * sx); } }
    f32x16 acc[2];
#pragma unroll
    for (int nt = 0; nt < 2; ++nt)
#pragma unroll
        for (int q = 0; q < 16; ++q) acc[nt][q] = 0.f;
#pragma unroll
    for (int sx = 0; sx < 8; ++sx)
#pragma unroll
        for (int nt = 0; nt < 2; ++nt) acc[nt] = MFMA32(af[sx], bfr[nt][sx], acc[nt]);
    LAS float* part = (LAS float*)lds;
    __syncthreads();
#pragma unroll
    for (int nt = 0; nt < 2; ++nt)
#pragma unroll
        for (int q = 0; q < 16; ++q) part[(w * 32 + (q & 3) + 8 * (q >> 2) + 4 * hh) * 64 + nt * 32 + l31] = acc[nt][q];
    __syncthreads();
    f32x4 sum = {0.f, 0.f, 0.f, 0.f};
#pragma unroll
    for (int ww = 0; ww < 8; ++ww) sum = sum + *(const LAS f32x4*)(part + (ww * 32 + row) * 64 + c4);
    f32x4 x = li == 0 ? xold : (f32x4){bf_lo(xbo.x), bf_hi(xbo.x), bf_lo(xbo.y), bf_hi(xbo.y)};
    x = x + gte * sum;
    { u32x2 o; o.x = cvtpk(x.x, x.y); o.y = cvtpk(x.z, x.w); *(u32x2*)(XB + (size_t)grow * 1024 + col) = o; }
    if (li < 3) {
        const f32x4 a = ngv * (scv + 1.f);
        const f32x4 xa = x * a; u32x2 o; o.x = cvtpk(xa.x, xa.y); o.y = cvtpk(xa.z, xa.w); *(u32x2*)((bf16_t*)(ws + WS_XA) + (size_t)grow * 1024 + col) = o;
    }
    float ss = (x.x * x.x + x.y * x.y) + (x.z * x.z + x.w * x.w);
    ss += __shfl_xor(ss, 1); ss += __shfl_xor(ss, 2); ss += __shfl_xor(ss, 4); ss += __shfl_xor(ss, 8);
    if ((tid & 15) == 0) unsafeAtomicAdd((float*)(ws + WS_SSQ) + ((size_t)(li + 1) * R + grow) * 4 + (ct >> 2), ss);
    __syncthreads();
}

DI float wave_sum(float v) {
#pragma unroll
    for (int o = 1; o < 64; o <<= 1) v += __shfl_xor(v, o);
    return v;
}
DI void transpose_item(const float* W, int K, int N, int ldW, bf16_t* WT, int row_off, LAS float* scr, int item, int lane) {
    const int nblk = N / 32, kb = item / nblk, nb = item % nblk, k0 = 64 * kb, n0 = 32 * nb;
    float tv[32];
#pragma unroll
    for (int i = 0; i < 32; ++i) tv[i] = W[(size_t)(k0 + 2 * i + (lane >> 5)) * ldW + n0 + (lane & 31)];
#pragma unroll
    for (int i = 0; i < 32; ++i) scr[(2 * i + (lane >> 5)) * 33 + (lane & 31)] = tv[i];
    asm volatile("s_waitcnt lgkmcnt(0)" ::: "memory");
    const int c = lane & 7;
#pragma unroll
    for (int j = 0; j < 4; ++j) { const int n = (lane >> 3) + 8 * j; const LAS float* s = scr + (8 * c) * 33 + n;
        u32x4 o; o.x = cvtpk(s[0 * 33], s[1 * 33]); o.y = cvtpk(s[2 * 33], s[3 * 33]); o.z = cvtpk(s[4 * 33], s[5 * 33]); o.w = cvtpk(s[6 * 33], s[7 * 33]);
        *(u32x4*)(WT + (size_t)(row_off + n0 + n) * K + k0 + 8 * c) = o; }
    asm volatile("s_waitcnt lgkmcnt(0)" ::: "memory");
}

template <int MODE> DI void gemv48_item(LAS unsigned char* lds, const float* s0, const float* s1, const float* W, int ldW, float* out, int ldo, const float* bias) {
    const int tid = opaque_tid(), lane = tid & 63, w = tid >> 6;
    LAS float* Sk = (LAS float*)lds;
    LAS float* Wc = (LAS float*)(lds + 49152);
    LAS float* part = (LAS float*)lds;
    float acc[48];
#pragma unroll
    for (int b = 0; b < 48; ++b) acc[b] = 0.f;
#pragma unroll 1
    for (int kc = 0; kc < 4; ++kc) {
        float sv[24], wv[32];
#pragma unroll
        for (int i = 0; i < 24; ++i) { const int e = tid + NTHR * i, b = e >> 8, k = kc * 256 + (e & 255);
            sv[i] = MODE == 0 ? (b < 32 ? s0[b * 1024 + k] : s1[(b - 32) * 1024 + k]) : s0[b * 3072 + k]; }
#pragma unroll
        for (int i = 0; i < 32; ++i) { const int e = tid + NTHR * i; wv[i] = W[(size_t)(kc * 256 + (e >> 6)) * ldW + (e & 63)]; }
        __syncthreads();
#pragma unroll
        for (int i = 0; i < 24; ++i) { float v = sv[i]; if (MODE == 0) v = v / (1.f + __expf(-v)); Sk[tid + NTHR * i] = v; }
#pragma unroll
        for (int i = 0; i < 32; ++i) Wc[tid + NTHR * i] = wv[i];
        __syncthreads();
#pragma unroll 2
        for (int k4 = 0; k4 < 8; ++k4) {
            const int kk = w * 32 + 4 * k4;
            const float w0 = Wc[kk * 64 + lane], w1 = Wc[(kk + 1) * 64 + lane], w2 = Wc[(kk + 2) * 64 + lane], w3 = Wc[(kk + 3) * 64 + lane];
#pragma unroll
            for (int b = 0; b < 48; ++b) { const f32x4 sx = *(const LAS f32x4*)(Sk + b * 256 + kk); acc[b] += (sx.x * w0 + sx.y * w1) + (sx.z * w2 + sx.w * w3); }
        }
    }
    __syncthreads();
#pragma unroll
    for (int b = 0; b < 48; ++b) part[(w * 48 + b) * 64 + lane] = acc[b];
    __syncthreads();
    for (int o = tid; o < 48 * 64; o += NTHR) { const int b = o >> 6, l = o & 63; float sum = 0.f;
#pragma unroll
        for (int ww = 0; ww < 8; ++ww) sum += part[(ww * 48 + b) * 64 + l];
        out[(size_t)b * ldo + l] = sum + (bias ? bias[l] : 0.f); }
    __syncthreads();
}

#define MFMA32G(a, b, c) __builtin_amdgcn_mfma_f32_32x32x16_bf16((a), (b), (c), 0, 0, 0)
DI void split_bf16(const float (&x)[8], bf16x8& hi, bf16x8& lo) {
    u32x4 h; h.x = cvtpk(x[0], x[1]); h.y = cvtpk(x[2], x[3]); h.z = cvtpk(x[4], x[5]); h.w = cvtpk(x[6], x[7]);
    u32x4 l; l.x = cvtpk(x[0] - bf_lo(h.x), x[1] - bf_hi(h.x)); l.y = cvtpk(x[2] - bf_lo(h.y), x[3] - bf_hi(h.y)); l.z = cvtpk(x[4] - bf_lo(h.z), x[5] - bf_hi(h.z)); l.w = cvtpk(x[6] - bf_lo(h.w), x[7] - bf_hi(h.w));
    hi = __builtin_bit_cast(bf16x8, h); lo = __builtin_bit_cast(bf16x8, l);
}
template <int MODE> DI void gemv48_mfma(LAS unsigned char* lds, const float* s0, const float* s1, const float* W, int ldW, float* out, int ldo, const float* bias) {
    const int tid = opaque_tid(), lane = tid & 63, w = __builtin_amdgcn_readfirstlane(tid >> 6), hh = lane >> 5, l31 = lane & 31;
    const int k0 = w * 128 + 8 * hh;
    const float* ar0 = MODE == 0 ? s0 + l31 * 1024 : s0 + l31 * 3072;
    const float* ar1 = MODE == 0 ? s1 + (l31 & 15) * 1024 : s0 + (32 + (l31 & 15)) * 3072;
    const bool v1 = l31 < 16;
    const float* wp = W + l31;
    f32x16 acc[2][2];
#pragma unroll
    for (int mt = 0; mt < 2; ++mt)
#pragma unroll
        for (int nt = 0; nt < 2; ++nt)
#pragma unroll
            for (int q = 0; q < 16; ++q) acc[mt][nt][q] = 0.f;
    f32x4 ra[2][2][2]; float rb[2][2][8];
#define GV_ISSUE(buf, sx) do { const int kk = k0 + 16 * (sx); \
        ra[buf][0][0] = *(const f32x4*)(ar0 + kk); ra[buf][0][1] = *(const f32x4*)(ar0 + kk + 4); ra[buf][1][0] = *(const f32x4*)(ar1 + kk); ra[buf][1][1] = *(const f32x4*)(ar1 + kk + 4); \
        _Pragma("unroll") for (int nt = 0; nt < 2; ++nt) _Pragma("unroll") for (int e = 0; e < 8; ++e) rb[buf][nt][e] = wp[(size_t)(kk + e) * ldW + nt * 32]; } while (0)
    GV_ISSUE(0, 0);
#pragma unroll
    for (int sx = 0; sx < 8; ++sx) {
        if (sx + 1 < 8) GV_ISSUE((sx + 1) & 1, sx + 1);
        bf16x8 ahi[2], alo[2], bhi[2], blo[2];
#pragma unroll
        for (int mt = 0; mt < 2; ++mt) {
            float x[8] = {ra[sx & 1][mt][0].x, ra[sx & 1][mt][0].y, ra[sx & 1][mt][0].z, ra[sx & 1][mt][0].w, ra[sx & 1][mt][1].x, ra[sx & 1][mt][1].y, ra[sx & 1][mt][1].z, ra[sx & 1][mt][1].w};
#pragma unroll
            for (int e = 0; e < 8; ++e) { if (MODE == 0) x[e] = x[e] / (1.f + __expf(-x[e])); if (mt == 1 && !v1) x[e] = 0.f; }
            split_bf16(x, ahi[mt], alo[mt]);
        }
#pragma unroll
        for (int nt = 0; nt < 2; ++nt) { float x[8];
#pragma unroll
            for (int e = 0; e < 8; ++e) x[e] = rb[sx & 1][nt][e];
            split_bf16(x, bhi[nt], blo[nt]); }
#pragma unroll
        for (int mt = 0; mt < 2; ++mt)
#pragma unroll
            for (int nt = 0; nt < 2; ++nt) { acc[mt][nt] = MFMA32G(ahi[mt], bhi[nt], acc[mt][nt]); acc[mt][nt] = MFMA32G(ahi[mt], blo[nt], acc[mt][nt]); acc[mt][nt] = MFMA32G(alo[mt], bhi[nt], acc[mt][nt]); }
    }
#undef GV_ISSUE
    LAS float* part = (LAS float*)lds;
    __syncthreads();
#pragma unroll
    for (int mt = 0; mt < 2; ++mt)
#pragma unroll
        for (int nt = 0; nt < 2; ++nt)
#pragma unroll
            for (int q = 0; q < 16; ++q) { const int b = mt * 32 + (q & 3) + 8 * (q >> 2) + 4 * hh; if (mt == 0 || q < 8) part[(w * 48 + b) * 64 + nt * 32 + l31] = acc[mt][nt][q]; }
    __syncthreads();
    for (int o = tid; o < 48 * 64; o += NTHR) { const int b = o >> 6, l = o & 63; float sum = 0.f;
#pragma unroll
        for (int ww = 0; ww < 8; ++ww) sum += part[(ww * 48 + b) * 64 + l];
        out[(size_t)b * ldo + l] = sum + (bias ? bias[l] : 0.f); }
    __syncthreads();
}

DI void blkdiag_item(LAS unsigned char* lds, const float* src, int ldsrc, int nrows, const float* Gm, float* out, int ch) {
    const int tid = opaque_tid();
    LAS float* sm = (LAS float*)lds;
    __syncthreads();
    for (int e = tid; e < 16 * 256; e += NTHR) { const int r = e >> 8, c4 = e & 255; f32x4 v = {0.f, 0.f, 0.f, 0.f}; if (r < nrows) v = *(const f32x4*)(src + (size_t)r * ldsrc + c4 * 4); *(LAS f32x4*)(sm + r * 1024 + c4 * 4) = v; }
    __syncthreads();
    const int c = ch * 512 + tid, g = c >> 8, cc = c & 255;
    const float* gp = Gm + (size_t)g * 65536 + cc;
    float acc[16];
#pragma unroll
    for (int r = 0; r < 16; ++r) acc[r] = 0.f;
#pragma unroll 1
    for (int i = 0; i < 256; i += 16) {
        float gv[16];
#pragma unroll
        for (int q = 0; q < 16; ++q) gv[q] = gp[(i + q) * 256];
#pragma unroll
        for (int q = 0; q < 16; q += 4)
#pragma unroll
            for (int r = 0; r < 16; ++r) { const f32x4 sx = *(const LAS f32x4*)(sm + r * 1024 + g * 256 + i + q); acc[r] += (sx.x * gv[q] + sx.y * gv[q + 1]) + (sx.z * gv[q + 2] + sx.w * gv[q + 3]); }
    }
#pragma unroll
    for (int r = 0; r < 16; ++r) if (r < nrows) out[(size_t)r * 1024 + c] = acc[r];
}

DI void blkdiag_mfma(const float* src, int ldsrc, int nrows, const float* Gm, float* out, int ch) {
    const int tid = opaque_tid(), lane = tid & 63, w = __builtin_amdgcn_readfirstlane(tid >> 6), hh = lane >> 5, l31 = lane & 31;
    const int c0 = ch * 512 + w * 64, g = c0 >> 8, cc0 = c0 & 255;
    const bool va = l31 < nrows;
    const float* ar = src + (size_t)(va ? l31 : 0) * ldsrc + g * 256 + 8 * hh;
    const float* bp = Gm + (size_t)g * 65536 + (size_t)(8 * hh) * 256 + cc0 + l31;
    f32x16 acc[2];
#pragma unroll
    for (int nt = 0; nt < 2; ++nt)
#pragma unroll
        for (int q = 0; q < 16; ++q) acc[nt][q] = 0.f;
    f32x4 ra[2][2]; float rb[2][2][8];
#define BD_ISSUE(buf, sx) do { ra[buf][0] = *(const f32x4*)(ar + 16 * (sx)); ra[buf][1] = *(const f32x4*)(ar + 16 * (sx) + 4); \
        _Pragma("unroll") for (int nt = 0; nt < 2; ++nt) _Pragma("unroll") for (int e = 0; e < 8; ++e) rb[buf][nt][e] = bp[(size_t)(16 * (sx) + e) * 256 + nt * 32]; } while (0)
    BD_ISSUE(0, 0);
#pragma unroll
    for (int sx = 0; sx < 16; ++sx) {
        if (sx + 1 < 16) BD_ISSUE((sx + 1) & 1, sx + 1);
        bf16x8 ahi, alo, bhi[2], blo[2];
        { float x[8] = {ra[sx & 1][0].x, ra[sx & 1][0].y, ra[sx & 1][0].z, ra[sx & 1][0].w, ra[sx & 1][1].x, ra[sx & 1][1].y, ra[sx & 1][1].z, ra[sx & 1][1].w};
#pragma unroll
          for (int e = 0; e < 8; ++e) if (!va) x[e] = 0.f;
          split_bf16(x, ahi, alo); }
#pragma unroll
        for (int nt = 0; nt < 2; ++nt) { float x[8];
#pragma unroll
            for (int e = 0; e < 8; ++e) x[e] = rb[sx & 1][nt][e];
            split_bf16(x, bhi[nt], blo[nt]); }
#pragma unroll
        for (int nt = 0; nt < 2; ++nt) { acc[nt] = MFMA32G(ahi, bhi[nt], acc[nt]); acc[nt] = MFMA32G(ahi, blo[nt], acc[nt]); acc[nt] = MFMA32G(alo, bhi[nt], acc[nt]); }
    }
#undef BD_ISSUE
#pragma unroll
    for (int nt = 0; nt < 2; ++nt)
#pragma unroll
        for (int q = 0; q < 8; ++q) { const int m = (q & 3) + 8 * (q >> 2) + 4 * hh; if (m < nrows) out[(size_t)m * 1024 + c0 + nt * 32 + l31] = acc[nt][q]; }
}

#undef MFMA32
constexpr int KPITCH = 72, VPITCH = 96  , LDS_VT = 192 * KPITCH * 2, RPITCH = 264  , LDS_QS = LDS_VT + 192 * VPITCH * 2, LDS_SS = LDS_QS + 64 * RPITCH * 2;
static_assert(LDS_SS + 64 * RPITCH * 2 <= LDS_MISC, "attention LDS map");
typedef short v4i16_t __attribute__((ext_vector_type(4)));
#define MFMA32(a, b, c) __builtin_amdgcn_mfma_f32_32x32x16_bf16((a), (b), (c), 0, 0, 0)
template <bool STAGED> DI void attn_compute(const LAS bf16_t* Ks, const LAS bf16_t* Vt, const bf16x8 (&qf)[4], int nkt, int dq0, int qi, int hh, int l31, int head, const float* sinks, const bf16_t* sgp, bf16_t* op, LAS bf16_t* sgl) {
    const int lane = hh * 32 + l31;
    u32x2 sgv[2][4];
#pragma unroll
    for (int mt = 0; mt < 2; ++mt)
#pragma unroll
        for (int jj = 0; jj < 4; ++jj) { sgv[mt][jj] = (u32x2){0u, 0u}; if (!STAGED) sgv[mt][jj] = *(const u32x2*)(sgp + mt * 32 + 8 * jj + 4 * hh); }
    f32x16 st[6];
#pragma unroll
    for (int kt = 0; kt < 6; ++kt) {
#pragma unroll
        for (int j = 0; j < 16; ++j) st[kt][j] = 0.f;
        if (kt < nkt) {
#pragma unroll
            for (int ks = 0; ks < 4; ++ks) { const bf16x8 a = *(const LAS bf16x8*)(Ks + (kt * 32 + l31) * KPITCH + ks * 16 + hh * 8); st[kt] = MFMA32(a, qf[ks], st[kt]); }
        }
    }
    const float slope2 = exp2f(-0.5f * (float)(head + 1)) * LOG2E;
    const float sink2 = sinks[head] * LOG2E;
    float dqf = (float)(dq0 + qi - 4 * hh); asm volatile("" : "+v"(dqf));
    float mx = sink2;
#pragma unroll
    for (int kt = 0; kt < 6; ++kt) if (kt < nkt) {
#pragma unroll
        for (int j = 0; j < 16; ++j) { const float kc = (float)(kt * 32 + (j & 3) + 8 * (j >> 2)); const float sv = st[kt][j] - slope2 * fabsf(dqf - kc); st[kt][j] = sv; mx = fmaxf(mx, sv); }
    }
    mx = fmaxf(mx, __shfl_xor(mx, 32));
    float sum = 0.f;
#pragma unroll
    for (int kt = 0; kt < 6; ++kt) if (kt < nkt) {
#pragma unroll
        for (int j = 0; j < 16; ++j) { const float pe = __builtin_amdgcn_exp2f(st[kt][j] - mx); st[kt][j] = pe; sum += pe; }
    }
    sum += __shfl_xor(sum, 32);
    const float inv = 1.f / (sum + __builtin_amdgcn_exp2f(sink2 - mx));
    f32x16 ot[2];
#pragma unroll
    for (int mt = 0; mt < 2; ++mt)
#pragma unroll
        for (int j = 0; j < 16; ++j) ot[mt][j] = 0.f;
#pragma unroll
    for (int kt = 0; kt < 6; ++kt) if (kt < nkt) {
#pragma unroll
        for (int sx = 0; sx < 2; ++sx) {
            u32x4 pw; pw.x = cvtpk(st[kt][8 * sx], st[kt][8 * sx + 1]); pw.y = cvtpk(st[kt][8 * sx + 2], st[kt][8 * sx + 3]); pw.z = cvtpk(st[kt][8 * sx + 4], st[kt][8 * sx + 5]); pw.w = cvtpk(st[kt][8 * sx + 6], st[kt][8 * sx + 7]);
            const bf16x8 pb = __builtin_bit_cast(bf16x8, pw);
#pragma unroll
            for (int mt = 0; mt < 2; ++mt) {
                const LAS bf16_t* vp = Vt + (kt * 32 + 16 * sx + 4 * hh + ((lane >> 2) & 3)) * VPITCH + mt * 32 + ((lane >> 4) & 1) * 16 + (lane & 3) * 4;
                const s16x4 lo = __builtin_bit_cast(s16x4, __builtin_amdgcn_ds_read_tr16_b64_v4i16((LAS v4i16_t*)vp)), hi = __builtin_bit_cast(s16x4, __builtin_amdgcn_ds_read_tr16_b64_v4i16((LAS v4i16_t*)(vp + 8 * VPITCH)));
                const bf16x8 a = {lo[0], lo[1], lo[2], lo[3], hi[0], hi[1], hi[2], hi[3]};
                ot[mt] = MFMA32(a, pb, ot[mt]);
            }
        }
    }
#pragma unroll
    for (int mt = 0; mt < 2; ++mt)
#pragma unroll
        for (int jj = 0; jj < 4; ++jj) {
            const int d0 = mt * 32 + 8 * jj + 4 * hh;
            u32x2 sg; if (STAGED) sg = *(const LAS u32x2*)(sgl + d0); else sg = sgv[mt][jj];
            u32x2 o; o.x = cvtpk(ot[mt][4 * jj] * inv * bf_lo(sg.x), ot[mt][4 * jj + 1] * inv * bf_hi(sg.x)); o.y = cvtpk(ot[mt][4 * jj + 2] * inv * bf_lo(sg.y), ot[mt][4 * jj + 3] * inv * bf_hi(sg.y));
            if (STAGED) *(LAS u32x2*)(sgl + d0) = o; else *(u32x2*)(op + d0) = o;
        }
}
DI void attn_decode(int item0, int rev, int& kvh, int& nkeys, int& qrow0, int& krow0, int& dq0) {
    const int item = rev ? 4095 - item0 : item0;
    kvh = item & 3; const int n = (item >> 2) & 31, b = item >> 7, nk = (n < 2 ? n : 2) + 1; nkeys = nk * 64; krow0 = b * 2048 + (n - nk + 1) * 64; qrow0 = b * 2048 + n * 64; dq0 = (nk - 1) * 64;
}
DI void attn_issue(int item, int rev, const bf16_t* KB, const bf16_t* VB, const bf16_t* Q, const bf16_t* SG, int tid, int lane, int w, u32x4 (&kr)[3], u32x4 (&vr)[3], u32x4 (&qr)[4], u32x4 (&sr)[4]) {
    int kvh, nkeys, qrow0, krow0, dq0; attn_decode(item, rev, kvh, nkeys, qrow0, krow0, dq0);
#pragma unroll
    for (int i = 0; i < 3; ++i) {
        const int pk = tid + NTHR * i;
        if (pk < nkeys * 8) kr[i] = *(const u32x4*)(KB + (size_t)(krow0 + (pk >> 3)) * 256 + kvh * 64 + (pk & 7) * 8);
        if (pk < nkeys * 8) vr[i] = *(const u32x4*)(VB + (size_t)(krow0 + (pk >> 3)) * 256 + kvh * 64 + (pk & 7) * 8);
    }
#pragma unroll
    for (int i = 0; i < 4; ++i) {
        const int pp = tid + NTHR * i; const size_t o = (size_t)(qrow0 + (pp >> 5)) * 1024 + kvh * 256 + (pp & 31) * 8;
        qr[i] = *(const u32x4*)(Q + o); sr[i] = *(const u32x4*)(SG + o);
    }
}
DI void attn_phase(LAS unsigned char* lds, const bf16_t* Q, const bf16_t* KB, const bf16_t* VB, const bf16_t* SG, bf16_t* OG, const float* ck, const float* cv, const float* sinks, int G, int bid, int rev) {
    const int tid = opaque_tid(), lane = tid & 63, w = __builtin_amdgcn_readfirstlane(tid >> 6), hh = lane >> 5, l31 = lane & 31;
    LAS bf16_t* Ks = (LAS bf16_t*)lds; LAS bf16_t* Vt = (LAS bf16_t*)(lds + LDS_VT);
    const int g = w >> 1, qhalf = w & 1, qi = qhalf * 32 + l31;
    LAS bf16_t* Qs = (LAS bf16_t*)(lds + LDS_QS); LAS bf16_t* Ss = (LAS bf16_t*)(lds + LDS_SS);
    u32x4 kr[3], vr[3], qr[4], sr[4];
#pragma unroll
    for (int i = 0; i < 3; ++i) { kr[i] = (u32x4){0u, 0u, 0u, 0u}; vr[i] = (u32x4){0u, 0u, 0u, 0u}; }
#pragma unroll
    for (int i = 0; i < 4; ++i) { qr[i] = (u32x4){0u, 0u, 0u, 0u}; sr[i] = (u32x4){0u, 0u, 0u, 0u}; }
    if (bid < 4096) attn_issue(bid, rev, KB, VB, Q, SG, tid, lane, w, kr, vr, qr, sr);
    for (int item = bid; item < 4096; item += G) {
        int kvh, nkeys, qrow0, krow0, dq0; attn_decode(item, rev, kvh, nkeys, qrow0, krow0, dq0);
        __syncthreads();
#pragma unroll
        for (int i = 0; i < 3; ++i) {
            const int pk = tid + NTHR * i;
            if (pk < nkeys * 8) { *(LAS u32x4*)(Ks + (pk >> 3) * KPITCH + (pk & 7) * 8) = kr[i]; *(LAS u32x4*)(Vt + (pk >> 3) * VPITCH + (pk & 7) * 8) = vr[i]; }
        }
#pragma unroll
        for (int i = 0; i < 4; ++i) { const int pp = tid + NTHR * i; *(LAS u32x4*)(Qs + (pp >> 5) * RPITCH + (pp & 31) * 8) = qr[i]; *(LAS u32x4*)(Ss + (pp >> 5) * RPITCH + (pp & 31) * 8) = sr[i]; }
        if (item + G < 4096) attn_issue(item + G, rev, KB, VB, Q, SG, tid, lane, w, kr, vr, qr, sr);
        __syncthreads();
        const int head = kvh * 4 + g;
        bf16x8 qf[4];
#pragma unroll
        for (int ks = 0; ks < 4; ++ks) qf[ks] = *(const LAS bf16x8*)(Qs + qi * RPITCH + g * 64 + ks * 16 + hh * 8);
        attn_compute<true>(Ks, Vt, qf, nkeys >> 5, dq0, qi, hh, l31, head, sinks, nullptr, nullptr, Ss + qi * RPITCH + g * 64);
        __syncthreads();
#pragma unroll
        for (int i = 0; i < 4; ++i) { const int pp = tid + NTHR * i; *(u32x4*)(OG + (size_t)(qrow0 + (pp >> 5)) * 1024 + kvh * 256 + (pp & 31) * 8) = *(const LAS u32x4*)(Ss + (pp >> 5) * RPITCH + (pp & 31) * 8); }
    }
    for (int e = bid; e < 64; e += G) {
        const int kvh = e & 3, sb = e >> 2, nkeys = 160, krow0 = MP + sb * 32 - 128, qrow0 = MP + sb * 32, dq0 = 128;
        __syncthreads();
        for (int pk = tid; pk < nkeys * 8; pk += NTHR) {
            const int key = pk >> 3, seg = pk & 7;
            u32x4 kk, vv;
            if (key < 128) { const size_t o = ((size_t)(sb * 128 + key) * 4 + kvh) * 64 + seg * 8;
                kk = pack8(*(const f32x4*)(ck + o), *(const f32x4*)(ck + o + 4)); vv = pack8(*(const f32x4*)(cv + o), *(const f32x4*)(cv + o + 4)); }
            else { const size_t o = (size_t)(krow0 + key) * 256 + kvh * 64 + seg * 8; kk = *(const u32x4*)(KB + o); vv = *(const u32x4*)(VB + o); }
            *(LAS u32x4*)(Ks + key * KPITCH + seg * 8) = kk;
            *(LAS u32x4*)(Vt + key * VPITCH + seg * 8) = vv;
        }
        const int head = kvh * 4 + g; const bool active = !qhalf; const size_t qrow = (size_t)(qrow0 + l31);
        bf16x8 qf[4];
#pragma unroll
        for (int ks = 0; ks < 4; ++ks) qf[ks] = (bf16x8){0, 0, 0, 0, 0, 0, 0, 0};
        if (active) {
#pragma unroll
            for (int ks = 0; ks < 4; ++ks) qf[ks] = *(const bf16x8*)(Q + qrow * 1024 + head * 64 + ks * 16 + hh * 8);
        }
        __syncthreads();
        if (active) attn_compute<false>(Ks, Vt, qf, nkeys >> 5, dq0, l31, hh, l31, head, sinks, SG + qrow * 1024 + head * 64, OG + qrow * 1024 + head * 64, nullptr);
    }
    __syncthreads();
}

template <int W> DI void pool_item(const bf16_t* V1, const bf16_t* SG, bf16_t* ZG, size_t rowb, int t0, int c0, const float (&sc)[8]) {
    constexpr int NR = 8;
    u32x4 vr[W - 1 + NR], sgr[NR];
#pragma unroll
    for (int i = 0; i < W - 1 + NR; ++i) { const int t = t0 - (W - 1) + i; vr[i] = (u32x4){0u, 0u, 0u, 0u}; if (t >= 0) vr[i] = *(const u32x4*)(V1 + (rowb + t) * 1024 + c0); }
#pragma unroll
    for (int i = 0; i < NR; ++i) sgr[i] = *(const u32x4*)(SG + (rowb + t0 + i) * 1024 + c0);
    float S[8];
#pragma unroll
    for (int e = 0; e < 8; ++e) S[e] = 0.f;
#pragma unroll
    for (int i = 0; i < W - 1; ++i) { float f[8]; unpack8(vr[i], f);
#pragma unroll
        for (int e = 0; e < 8; ++e) S[e] += f[e]; }
#pragma unroll
    for (int tt = 0; tt < NR; ++tt) {
        float cur[8], sg[8], old[8], z[8];
        unpack8(vr[W - 1 + tt], cur); unpack8(sgr[tt], sg); unpack8(vr[tt], old);
#pragma unroll
        for (int e = 0; e < 8; ++e) sg[e] = silu_f(sg[e]);
        const int t = t0 + tt; const float rn = 1.f / (float)(t + 1 < W ? t + 1 : W);
#pragma unroll
        for (int e = 0; e < 8; ++e) { S[e] += cur[e]; z[e] = (S[e] * rn - cur[e]) * sc[e] * sg[e]; S[e] -= old[e]; }
        u32x4 o; o.x = cvtpk(z[0], z[1]); o.y = cvtpk(z[2], z[3]); o.z = cvtpk(z[4], z[5]); o.w = cvtpk(z[6], z[7]);
        *(u32x4*)(ZG + (rowb + t) * 1024 + c0) = o;
    }
}
template <int W> DI void pool_sample_rows(const bf16_t* V1, const bf16_t* SG, bf16_t* ZG, const bf16_t* hvp, size_t rowb, int t0, int c0, const float (&sc)[8]) {
    const float rn = 1.f / (float)W;
#pragma unroll 1
    for (int t = t0; t < t0 + 8; ++t) {
        u32x4 r[W];
#pragma unroll
        for (int j = 0; j < W; ++j) { const int te = t - j; const bf16_t* p = te >= 0 ? V1 + (rowb + te) * 1024 + c0 : hvp + (size_t)(15 + te) * 1024 + c0; r[j] = *(const u32x4*)p; }
        const u32x4 sgw = *(const u32x4*)(SG + (rowb + t) * 1024 + c0);
        float S[8], cur[8], sg[8], z[8];
#pragma unroll
        for (int e = 0; e < 8; ++e) S[e] = 0.f;
#pragma unroll
        for (int j = 0; j < W; ++j) { float f[8]; unpack8(r[j], f);
#pragma unroll
            for (int e = 0; e < 8; ++e) S[e] += f[e]; }
        unpack8(r[0], cur); unpack8(sgw, sg);
#pragma unroll
        for (int e = 0; e < 8; ++e) z[e] = (S[e] * rn - cur[e]) * sc[e] * silu_f(sg[e]);
        u32x4 o; o.x = cvtpk(z[0], z[1]); o.y = cvtpk(z[2], z[3]); o.z = cvtpk(z[4], z[5]); o.w = cvtpk(z[6], z[7]);
        *(u32x4*)(ZG + (rowb + t) * 1024 + c0) = o;
    }
}
DI void pool_phase(const bf16_t* V1, const bf16_t* SG, bf16_t* ZG, const float* pscale, const bf16_t* hv, int G, int bid, int rev) {
    const int tid = opaque_tid(), lane = tid & 63, wave = __builtin_amdgcn_readfirstlane(tid >> 6);
    const int g = wave & 3, sub = (wave >> 2) * 2 + (lane >> 5), c0 = g * 256 + (lane & 31) * 8, w = 2 << g;
    float sc[8];
    { const f32x4 a = *(const f32x4*)(pscale + c0), b = *(const f32x4*)(pscale + c0 + 4); sc[0] = a.x; sc[1] = a.y; sc[2] = a.z; sc[3] = a.w; sc[4] = b.x; sc[5] = b.y; sc[6] = b.z; sc[7] = b.w; }
    for (int it0 = bid; it0 < 2048; it0 += G) {
        const int item = rev ? 2047 - it0 : it0;
        const size_t rowb = (size_t)(item >> 6) * 2048; const int t0 = (item & 63) * 32 + sub * 8;
        if (g == 0) pool_item<2>(V1, SG, ZG, rowb, t0, c0, sc); else if (g == 1) pool_item<4>(V1, SG, ZG, rowb, t0, c0, sc);
        else if (g == 2) pool_item<8>(V1, SG, ZG, rowb, t0, c0, sc); else pool_item<16>(V1, SG, ZG, rowb, t0, c0, sc);
    }
    for (int sb = bid; sb < 16; sb += G) {
        const size_t rowb = (size_t)MP + sb * 32; const int t0 = sub * 8; const bf16_t* hvp = hv + (size_t)sb * 15 * 1024;
        if (g == 0) pool_sample_rows<2>(V1, SG, ZG, hvp, rowb, t0, c0, sc); else if (g == 1) pool_sample_rows<4>(V1, SG, ZG, hvp, rowb, t0, c0, sc);
        else if (g == 2) pool_sample_rows<8>(V1, SG, ZG, hvp, rowb, t0, c0, sc); else pool_sample_rows<16>(V1, SG, ZG, hvp, rowb, t0, c0, sc);
    }
}

#define RLX_AGENT __ATOMIC_RELAXED, __HIP_MEMORY_SCOPE_AGENT
#define XB_TMO      128
#define XB_XCNT(j)  (256  + 64 * (j))
#define XB_XSUB(j)  (1280 + 64 * (j))
#define XB_XGEN(j)  (2304 + 64 * (j))
#define XB_TOP      3328
#define XB_TOPGEN   3392
#define XCD_BAR_WORDS 3456
#define XB_SPIN_CAP (1u << 18)

__device__ __forceinline__ unsigned xb_ld(unsigned* p)              { return __hip_atomic_load(p, __ATOMIC_RELAXED, __HIP_MEMORY_SCOPE_AGENT); }
__device__ __forceinline__ unsigned xb_add(unsigned* p, unsigned v) { return __hip_atomic_fetch_add(p, v, __ATOMIC_RELAXED, __HIP_MEMORY_SCOPE_AGENT); }
__device__ __forceinline__ unsigned xb_xcc_id() { return (unsigned)__builtin_amdgcn_s_getreg((3 << 11) | 20) & 0xFu; }
#define XB_SPIN(cond, bar) do { unsigned _sp = 0; while (cond) { __builtin_amdgcn_s_sleep(1); \
    if ((++_sp & 255u) == 0u) { if (xb_ld(&(bar)[XB_TMO])) break; if (_sp > XB_SPIN_CAP) { atomicAdd(&(bar)[XB_TMO], 1u); break; } } } } while (0)

struct XcdBarrier {
    unsigned* bar; unsigned x;
    volatile LAS unsigned* st;
};

__device__ __forceinline__ XcdBarrier xcd_barrier_post(unsigned* bar, volatile LAS unsigned* st) {
    XcdBarrier b; b.bar = bar; b.x = xb_xcc_id(); b.st = st;
    if (threadIdx.x == 0) (void)xb_add(&bar[XB_XCNT(b.x)], 1u);
    return b;
}
__device__ __forceinline__ void xcd_barrier_complete(unsigned* bar, unsigned x, unsigned& nloc, unsigned& nx) {
    const unsigned G = gridDim.x * gridDim.y * gridDim.z;
    unsigned sum, cnt, mine, sp = 0u;
    for (;;) {
        sum = 0u; cnt = 0u; mine = 0u;
#pragma unroll
        for (unsigned j = 0; j < 16; ++j) { const unsigned c = xb_ld(&bar[XB_XCNT(j)]); sum += c; cnt += (c > 0u) ? 1u : 0u; mine = (j == x) ? c : mine; }
        if (sum == G) break;
        __builtin_amdgcn_s_sleep(1);
        if ((++sp & 255u) == 0u) { if (xb_ld(&bar[XB_TMO])) break; if (sp > XB_SPIN_CAP) { atomicAdd(&bar[XB_TMO], 1u); break; } }
    }
    nloc = mine > 0u ? mine : 1u; nx = cnt > 0u ? cnt : 1u;
}

__device__ __forceinline__ void xcd_barrier(const XcdBarrier& b) {
    asm volatile("s_waitcnt vmcnt(0)" ::: "memory");
    __syncthreads();
    if (threadIdx.x == 0) {
        unsigned* bar = b.bar;
        __builtin_amdgcn_s_waitcnt(0);
        unsigned nloc = b.st[0], nx = b.st[1];
        if (nloc == 0u) { xcd_barrier_complete(bar, b.x, nloc, nx); b.st[0] = nloc; b.st[1] = nx; }
        const unsigned old = xb_add(&bar[XB_XSUB(b.x)], 1u);
        const unsigned gen = old / nloc;
        if (old + 1u == (gen + 1u) * nloc) {
            __builtin_amdgcn_fence(__ATOMIC_RELEASE, "agent");
            asm volatile("s_waitcnt vmcnt(0)" ::: "memory");
            const unsigned og = xb_add(&bar[XB_TOP], 1u);
            const unsigned tg = og / nx;
            if (og + 1u == (tg + 1u) * nx) xb_add(&bar[XB_TOPGEN], 1u);
            else XB_SPIN(xb_ld(&bar[XB_TOPGEN]) == tg, bar);
            __builtin_amdgcn_fence(__ATOMIC_ACQUIRE, "agent");
            xb_add(&bar[XB_XGEN(b.x)], 1u);
            asm volatile("s_waitcnt vmcnt(0)" ::: "memory");
        } else {
            XB_SPIN(xb_ld(&bar[XB_XGEN(b.x)]) == gen, bar);
            __builtin_amdgcn_fence(__ATOMIC_ACQUIRE, "agent");
            asm volatile("s_waitcnt vmcnt(0)" ::: "memory");
        }
    }
    __syncthreads();
}

constexpr int N_PHASES = 15;

__global__ void __launch_bounds__(NTHR, 2) mk_fwd(Args args) {
    extern __shared__ __attribute__((aligned(16))) unsigned char lds_raw[];
    LAS unsigned char* lds = (LAS unsigned char*)lds_raw;
    cg::grid_group grid = cg::this_grid();
    KArgs ka = (KArgs)__builtin_amdgcn_kernarg_segment_ptr();
    if (threadIdx.x < 2) ((LAS unsigned*)(lds + LDS_MISC))[threadIdx.x] = 0u;
    __syncthreads();
#ifndef USE_XBAR
#define USE_XBAR 1
#endif
#ifndef HOST_ZERO_BAR
#define HOST_ZERO_BAR 1
#endif
    XcdBarrier xbar; xbar.bar = nullptr; xbar.x = 0; xbar.st = (volatile LAS unsigned*)(lds + LDS_MISC);
    if (HOST_ZERO_BAR && USE_XBAR && ka->ph_hi - ka->ph_lo > 1) xbar = xcd_barrier_post((unsigned*)(ka->ws + WS_BAR), (volatile LAS unsigned*)(lds + LDS_MISC));
    const int ph_hi = ka->ph_hi;
#define IN_(i) ((const float*)ka->in[i])
#define x_prompt IN_(0)
#define x_sample IN_(1)
#define c_prompt IN_(2)
#define c_sample IN_(3)
#define cache_pool IN_(4)
#define cache_k IN_(5)
#define cache_v IN_(6)
#define norm_g IN_(7)
#define ada_w IN_(8)
#define ada_b IN_(9)
#define pool_w_in IN_(10)
#define pool_w_grp IN_(11)
#define pool_scale IN_(12)
#define pool_w_out IN_(13)
#define attn_w_in IN_(14)
#define attn_sinks IN_(15)
#define attn_w_out IN_(16)
#define final_g IN_(17)
#define out ((float*)ka->out)
#define ws ((unsigned char*)ka->ws)
#define ssq ((float*)(ws + WS_SSQ))
#define mod ((float*)(ws + WS_MOD))
#define biasv ((float*)(ws + WS_BIAS))
#define Wp ((float*)(ws + WS_WP))
#define hv ((float*)(ws + WS_HV))
#define poolBt ((bf16_t*)(ws + WS_POOLBT))
#define attnBt ((bf16_t*)(ws + WS_ATTNBT))
#define poolOutBt ((bf16_t*)(ws + WS_POOLOUT))
#define attnOutBt ((bf16_t*)(ws + WS_ATTNOUT))
#define XA ((bf16_t*)(ws + WS_XA))
#define B1 ((bf16_t*)(ws + WS_B1))
#define B2 ((bf16_t*)(ws + WS_B2))
#define B3 ((bf16_t*)(ws + WS_B3))
#define KBuf ((bf16_t*)(ws + WS_KB))
#define VBuf ((bf16_t*)(ws + WS_VB))
    for (int ph = ka->ph_lo; ph < ph_hi; ++ph) {
#ifndef DUP_MASK
#define DUP_MASK 0
#endif
        const int dupk = ph == 4 ? 5 : ph < 2 ? 0 : (ph == N_PHASES - 1 ? 3 : ((ph - 2) % 3 == 1 ? ((((ph - 2) / 3) & 1) ? 4 : 1) : ((ph - 2) % 3 == 0 ? 2 : 3)));
        const int nrep = 1 + ((DUP_MASK >> dupk) & 1);
        for (int rep = 0; rep < nrep; ++rep) {
        int G, bid; asm volatile("s_mov_b32 %0, %2\n\ts_mov_b32 %1, %3" : "=s"(G), "=s"(bid) : "s"((int)gridDim.x), "s"((int)blockIdx.x));
        const int tid = opaque_tid(), lane = tid & 63, wave = __builtin_amdgcn_readfirstlane(tid >> 6);
        const int gw = bid * NWAVES + wave, NGW = G * NWAVES;
#ifndef USE_REV
#define USE_REV 1
#endif
        const int PH_REV = USE_REV ? ((ph + 1) & 1) : 0;
        if (ph == 0) {
            if (!HOST_ZERO_BAR && bid == 0) for (int i = tid; i < XCD_BAR_WORDS; i += NTHR) ((unsigned*)(ws + WS_BAR))[i] = 0u;
            if (SMALL_OUT) for (int i = bid * NTHR + tid; i < 4 * 2048; i += G * NTHR) ssq[((size_t)((i >> 11) + 1) * R + MP) * 4 + (i & 2047)] = 0.f;
            for (int i = bid * NTHR + tid; i < 2 * 16 * 96 * 64; i += G * NTHR) { const int c4 = i & 63, r = (i >> 6) % 96, jsb = i / (64 * 96);
                const size_t so = ((size_t)jsb * 128 + 32 + r) * 256 + c4 * 4, dofs = ((size_t)jsb * 128 + r) * 256 + c4 * 4;
                *(f32x4*)(out + OFF_KS + dofs) = *(const f32x4*)(cache_k + so); *(f32x4*)(out + OFF_VS + dofs) = *(const f32x4*)(cache_v + so); }
            for (int it = bid; it < 192; it += G) { const int i = it / 48, ch = it % 48;
                gemv48_mfma<0>(lds, c_prompt, c_sample, ada_w + (size_t)i * 1024 * 3072 + ch * 64, 3072, mod + (size_t)i * NB * 3072 + ch * 64, 3072, ada_b + i * 3072 + ch * 64); }
            for (int it = (bid + 64) % G; it < 320; it += G) {
                if (it < 256) { const int j = it >> 7, kb = (it >> 1) & 63, ch = it & 1;
                    blkdiag_mfma(pool_w_in + (size_t)j * 1024 * 2048 + (size_t)kb * 16 * 2048, 2048, 16, pool_w_grp + (size_t)j * 4 * 65536, Wp + (size_t)j * 1048576 + (size_t)kb * 16 * 1024, ch); }
                else { const int e = it - 256, j = e >> 5, sb = (e >> 1) & 15, ch = e & 1;
                    blkdiag_mfma(cache_pool + ((size_t)j * 16 + sb) * 15 * 1024, 1024, 15, pool_w_grp + (size_t)j * 4 * 65536, hv + ((size_t)j * 16 + sb) * 15 * 1024, ch); }
            }
            __syncthreads();
            LAS float* scr = (LAS float*)(lds + wave * 16384);
            for (int it = gw; it < 2 * 3328; it += NGW) { const int j = it / 3328; int r = it % 3328;
                if (r < 1280) { transpose_item(attn_w_in + (size_t)j * 1024 * 2560, 1024, 2560, 2560, attnBt + (size_t)j * 2560 * 1024, 0, scr, r, lane); continue; } r -= 1280;
                if (r < 512) { transpose_item(attn_w_out + (size_t)j * 1048576, 1024, 1024, 1024, attnOutBt + (size_t)j * 1048576, 0, scr, r, lane); continue; } r -= 512;
                if (r < 512) { transpose_item(pool_w_out + (size_t)j * 1048576, 1024, 1024, 1024, poolOutBt + (size_t)j * 1048576, 0, scr, r, lane); continue; } r -= 512;
                if (r < 512) { transpose_item(pool_w_in + (size_t)j * 1024 * 2048 + 1024, 1024, 1024, 2048, poolBt + (size_t)j * 3072 * 1024, 1024, scr, r, lane); continue; } r -= 512;
                transpose_item(pool_w_in + (size_t)j * 1024 * 2048, 1024, 1024, 2048, poolBt + (size_t)j * 3072 * 1024, 2048, scr, r, lane); }
        } else if (ph == 1) {
            for (int it = bid; it < 176; it += G) {
                if (it < 96) { const int j = it / 48, ch = it % 48; const float* W; int ldW;
                    if (ch < 16) { W = Wp + (size_t)j * 1048576 + ch * 64; ldW = 1024; } else if (ch < 32) { W = pool_w_in + (size_t)j * 1024 * 2048 + 1024 + (ch - 16) * 64; ldW = 2048; } else { W = pool_w_in + (size_t)j * 1024 * 2048 + (ch - 32) * 64; ldW = 2048; }
                    gemv48_mfma<1>(lds, mod + (size_t)(2 * j) * NB * 3072, nullptr, W, ldW, biasv + (size_t)(2 * j) * NB * 3072 + ch * 64, 3072, nullptr); }
                else { const int e = it - 96, j = e / 40, ch = e % 40;
                    gemv48_mfma<1>(lds, mod + (size_t)(2 * j + 1) * NB * 3072, nullptr, attn_w_in + (size_t)j * 1024 * 2560 + ch * 64, 2560, biasv + (size_t)(2 * j + 1) * NB * 3072 + ch * 64, 3072, nullptr); }
            }
            __syncthreads();
            LAS float* scr = (LAS float*)(lds + wave * 16384);
            for (int i = bid * NTHR + tid; i < 2 * 16 * 15 * 1024 / 8; i += G * NTHR) *(u32x4*)((bf16_t*)(ws + WS_HVB) + (size_t)i * 8) = pack8(*(const f32x4*)(hv + (size_t)i * 8), *(const f32x4*)(hv + (size_t)i * 8 + 4));
            for (int it = gw; it < 1024; it += NGW) { const int j = it >> 9; transpose_item(Wp + (size_t)j * 1048576, 1024, 1024, 1024, poolBt + (size_t)j * 3072 * 1024, 0, scr, it & 511, lane); }
            for (int rr0 = gw * 4; rr0 < R; rr0 += NGW * 4) {
                const int row0 = PH_REV ? R - 4 - rr0 : rr0;
                const int mb = row_mb(row0); const float* xr = row0 < MP ? x_prompt + (size_t)row0 * 1024 : x_sample + (size_t)(row0 - MP) * 1024;
                const float* ngp = norm_g; const float* scp = mod + (size_t)mb * 3072 + 1024;
                f32x4 v[4][4], a4[4];
#pragma unroll
                for (int r = 0; r < 4; ++r)
#pragma unroll
                    for (int j = 0; j < 4; ++j) v[r][j] = *(const f32x4*)(xr + (size_t)r * 1024 + 4 * lane + 256 * j);
#pragma unroll
                for (int j = 0; j < 4; ++j) { const int c = 4 * lane + 256 * j; a4[j] = *(const f32x4*)(ngp + c) * (*(const f32x4*)(scp + c) + 1.f); }
#pragma unroll
                for (int r = 0; r < 4; ++r) { float sq = 0.f;
#pragma unroll
                    for (int j = 0; j < 4; ++j) { const f32x4 x4 = v[r][j]; sq += (x4.x * x4.x + x4.y * x4.y) + (x4.z * x4.z + x4.w * x4.w);
                        const f32x4 a = x4 * a4[j]; u32x2 o; o.x = cvtpk(a.x, a.y); o.y = cvtpk(a.z, a.w); *(u32x2*)(XA + (size_t)(row0 + r) * 1024 + 4 * lane + 256 * j) = o; }
                    sq = wave_sum(sq); if (lane == 0) *(f32x4*)(ssq + (size_t)(row0 + r) * 4) = (f32x4){sq, 0.f, 0.f, 0.f}; }
            }
        } else if (ph == N_PHASES - 1) {
            for (int rr0 = gw * 4; rr0 < R; rr0 += NGW * 4) {
                const int row0 = PH_REV ? R - 4 - rr0 : rr0;
                f32x4 v[4][4], gf[4]; float rs[4];
#pragma unroll
                for (int r = 0; r < 4; ++r) { const f32x4 sp = *(const f32x4*)(ssq + ((size_t)4 * R + row0 + r) * 4); rs[r] = (sp.x + sp.y) + (sp.z + sp.w);
#pragma unroll
                    for (int j = 0; j < 4; ++j) { const u32x2 xb = *(const u32x2*)((const bf16_t*)(ws + WS_XB) + (size_t)(row0 + r) * 1024 + 4 * lane + 256 * j); v[r][j] = (f32x4){bf_lo(xb.x), bf_hi(xb.x), bf_lo(xb.y), bf_hi(xb.y)}; } }
#pragma unroll
                for (int j = 0; j < 4; ++j) gf[j] = *(const f32x4*)(final_g + 4 * lane + 256 * j);
#pragma unroll
                for (int r = 0; r < 4; ++r) { const float rr = rsqrtf(rs[r] * (1.f / 1024.f) + EPS);
#pragma unroll
                    for (int j = 0; j < 4; ++j) *(f32x4*)(out + (size_t)(row0 + r) * 1024 + 4 * lane + 256 * j) = v[r][j] * rr * gf[j]; }
            }
        } else {
            const int li = (ph - 2) / 3, k = (ph - 2) % 3, j = li >> 1, attn = li & 1;
            if (k == 0) {
                pg8::Gemm g{XA, attn ? attnBt + (size_t)j * 2560 * 1024 : poolBt + (size_t)j * 3072 * 1024, R, attn ? 2560 : 2048, 1024};
                pg8::TileOrder S; S.init(R / 256, attn ? 10 : 8, G, bid, attn ? 0 : 136, PH_REV, WGM_IN);
                EpiIn E{li | (EPI_PROBE ? rep * EPI_PROBE * 256 : 0), ka, lds};
                pg8::gemm_phase<EpiIn, pg8::TileOrder, true, true>(lds, g, S, E);
            } else if (k == 1) {
                if (!attn) pool_phase(B1, B2, B3, pool_scale + j * 1024, (const bf16_t*)(ws + WS_HVB) + (size_t)j * 16 * 15 * 1024, G, bid, PH_REV);
                else attn_phase(lds, B1, KBuf, VBuf, B2, B3, cache_k + (size_t)j * 16 * 128 * 256, cache_v + (size_t)j * 16 * 128 * 256, attn_sinks + j * 16, G, bid, PH_REV);
            } else {
                pg8::Gemm g{B3, attn ? attnOutBt + (size_t)j * 1048576 : poolOutBt + (size_t)j * 1048576, R, 1024, 1024};
                if (SMALL_OUT) { for (int ti = bid; ti < 256; ti += G) small_out_tile(lds, ti, li, ka); }
                pg8::TileOrder S; S.init(SMALL_OUT ? 256 : R / 256, 4, G, bid, 0, PH_REV, WGM_OUT);
                EpiOut E{li | (rep << 8), ka, lds};
                pg8::gemm_phase<EpiOut, pg8::TileOrder, true, true>(lds, g, S, E);
            }
        }
#ifndef SYNC_REP
#define SYNC_REP 1
#endif
#ifndef USE_XBAR
#define USE_XBAR 1
#endif
        if (ph + 1 < ph_hi || rep + 1 < nrep) {
            for (int sr = 0; sr < SYNC_REP; ++sr) {
                if (USE_XBAR && xbar.bar) xcd_barrier(xbar);
                else { grid.sync(); if (USE_XBAR && ph == 0) xbar = xcd_barrier_post((unsigned*)(ws + WS_BAR), (volatile LAS unsigned*)(lds + LDS_MISC)); }
            }
        }
        }
    }
}

#undef out
#undef ws
#undef ssq
#undef mod
#undef biasv
#undef Wp
#undef hv
#undef XA
#undef B1
#undef B2
#undef B3
#ifndef MK_SPLIT
#define MK_SPLIT 0
#endif
extern "C" void kernel_launch(void* const* d_in, const int* in_sizes, int n_in, void* d_out, int out_size, void* d_ws, size_t ws_size, hipStream_t stream) {
    static int grid = 0;
    if (grid == 0) {
        if (n_in != 18 || out_size != (int)OUT_TOTAL || ws_size < WS_END) { fprintf(stderr, "kernel_launch: unexpected shapes (n_in %d, out %d, ws %zu)\n", n_in, out_size, ws_size); grid = -1; return; }
        int dev = 0, cus = 0, per_cu = 0;
        (void)hipGetDevice(&dev); (void)hipDeviceGetAttribute(&cus, hipDeviceAttributeMultiprocessorCount, dev);
        if (hipFuncSetAttribute((const void*)mk_fwd, hipFuncAttributeMaxDynamicSharedMemorySize, LDS_BYTES) != hipSuccess) { fprintf(stderr, "kernel_launch: hipFuncSetAttribute failed\n"); grid = -1; return; }
        if (hipOccupancyMaxActiveBlocksPerMultiprocessor(&per_cu, (const void*)mk_fwd, NTHR, LDS_BYTES) != hipSuccess || per_cu < 1) { fprintf(stderr, "kernel_launch: occupancy query failed (%d)\n", per_cu); per_cu = 1; }
        (void)hipGetLastError();
        grid = cus * per_cu;
        if (grid <= 0) { grid = -1; return; }
    }
    if (grid < 0) return;
    Args a{};
    for (int i = 0; i < 18; ++i) a.in[i] = (const float*)d_in[i];
    a.out = (float*)d_out; a.ws = (unsigned char*)d_ws;
#if MK_SPLIT
    for (int ph = 0; ph < N_PHASES; ++ph) { a.ph_lo = ph; a.ph_hi = ph + 1; hipLaunchKernelGGL(mk_fwd, dim3(grid), dim3(NTHR), LDS_BYTES, stream, a); }
#else
    a.ph_lo = 0; a.ph_hi = N_PHASES;
    if (HOST_ZERO_BAR && hipMemsetAsync((unsigned char*)d_ws + WS_BAR, 0, XCD_BAR_WORDS * 4, stream) != hipSuccess) { fprintf(stderr, "kernel_launch: hipMemsetAsync of the barrier words failed\n"); return; }
    void* kargs[] = {&a};
    hipError_t e = hipLaunchCooperativeKernel((const void*)mk_fwd, dim3(grid), dim3(NTHR), kargs, LDS_BYTES, stream);
    if (e != hipSuccess) fprintf(stderr, "kernel_launch: cooperative launch failed: %s (grid %d)\n", hipGetErrorString(e), grid);
#endif
}
```
